# Optimizing an MI355X kernel written in HIP

```python
import math
import jax, jax.numpy as jnp
from jax import lax
import numpy as np

D_MODEL = 1024
BATCH = 8
SEQ = 8192
DEPTH = 1
DEC_BATCH = 32
DEC_SEQ = 16
PAST_LEN = 1024

CHUNK = 64
N_HEADS = 16
HEAD_DIM = 64
KV_HEADS = 4
GROUP = N_HEADS // KV_HEADS
IDX_HEADS = 8
IDX_DIM = 64
TOPK_MAX = 256
Q_BLOCK = 128
GM_CHUNK = 128
GM_GROUPS = 4
GM_WIDTH = D_MODEL
GM_GROUP_DIM = GM_WIDTH // GM_GROUPS
D_FF = 2816
REL_BUCKETS = 32
REL_MAX_DIST = 128
LN_EPS = 1e-5
ALPHA = (2 * DEPTH) ** 0.25
BETA = (8 * DEPTH) ** -0.25
ATT_Q = N_HEADS * HEAD_DIM
ATT_KV = KV_HEADS * HEAD_DIM
IDX_Q = IDX_HEADS * IDX_DIM
IN_SPLITS = (ATT_Q, ATT_KV, ATT_KV, IDX_Q, IDX_DIM, IDX_HEADS, 2 * GM_WIDTH, D_MODEL, D_MODEL)
IN_WIDTH = ATT_Q + 2 * ATT_KV + IDX_Q + IDX_DIM + IDX_HEADS + 2 * GM_WIDTH + 2 * D_MODEL

kernel_name = "dsa_gmlp_gated_streaming_encoder_step"


def layer_norm(x, g, b):
    xf = x.astype(jnp.float32)
    mu = jnp.mean(xf, axis=-1, keepdims=True)
    var = jnp.mean(jnp.square(xf - mu), axis=-1, keepdims=True)
    return ((xf - mu) * lax.rsqrt(var + LN_EPS)).astype(x.dtype) * g + b


def swiglu(x, wg, wu, wd):
    return (jax.nn.silu(x @ wg) * (x @ wu)) @ wd


def rel_bucket(rel):
    half = REL_BUCKETS // 2
    max_exact = half // 2
    ret = jnp.where(rel > 0, half, 0)
    n = jnp.abs(rel)
    nf = jnp.maximum(n, 1).astype(jnp.float32)
    large = max_exact + (jnp.log(nf / max_exact) / math.log(REL_MAX_DIST / max_exact)
                         * (half - max_exact)).astype(jnp.int32)
    large = jnp.minimum(large, half - 1)
    return ret + jnp.where(n < max_exact, n, large)


def dsa_attend(q, qi, wi, q_pos, n_vis, k, v, ki, rel_table, n_sel):
    f32 = jnp.float32
    B, Q = q.shape[:2]
    L = k.shape[1]
    dots = jnp.einsum('bqhd,bsd->bqhs', qi, ki).astype(f32) * IDX_DIM ** -0.5
    score = jnp.einsum('bqhs,bqh->bqs', jax.nn.relu(dots), wi.astype(f32)) * IDX_HEADS ** -0.5
    key_ok = jnp.arange(L, dtype=jnp.int32)[None, :] < n_vis[:, None]
    score = jnp.where(key_ok[None], score, -jnp.inf)
    _, sel = lax.top_k(score, n_sel)
    valid = sel < n_vis[None, :, None]
    gather = jax.vmap(lambda rows, ids: rows[ids])
    kg = gather(k, sel)
    vg = gather(v, sel)
    qg = q.reshape(B, Q, KV_HEADS, GROUP, HEAD_DIM)
    logits = jnp.einsum('bqkgd,bqnkd->bqkgn', qg, kg).astype(f32) * HEAD_DIM ** -0.5
    bias = rel_table[rel_bucket(sel - q_pos[None, :, None])].astype(f32)
    bias = bias.reshape(B, Q, n_sel, KV_HEADS, GROUP).transpose(0, 1, 3, 4, 2)
    logits = jnp.where(valid[:, :, None, None, :], logits + bias, -1e30)
    p = jax.nn.softmax(logits, axis=-1).astype(v.dtype)
    out = jnp.einsum('bqkgn,bqnkd->bqkgd', p, vg)
    return out.reshape(B, Q, N_HEADS * HEAD_DIM)


def dsa_prompt(q, qi, wi, k, v, ki, rel_table):
    B, S = q.shape[:2]
    nb = S // Q_BLOCK
    n_sel = min(TOPK_MAX, S // 4)
    pos = jnp.arange(S, dtype=jnp.int32)
    n_vis = (pos // CHUNK + 1) * CHUNK

    def blk(a):
        return jnp.swapaxes(a.reshape(B, nb, Q_BLOCK, *a.shape[2:]), 0, 1)

    def one(args):
        qb, qib, wib, pb, vb = args
        return dsa_attend(qb, qib, wib, pb, vb, k, v, ki, rel_table, n_sel)

    out = lax.map(one, (blk(q), blk(qi), blk(wi), pos.reshape(nb, Q_BLOCK), n_vis.reshape(nb, Q_BLOCK)))
    return jnp.swapaxes(out, 0, 1).reshape(B, S, N_HEADS * HEAD_DIM)


def spatial_gate(u, v, w_s, b_s):
    B, T = u.shape[:2]
    rows = min(T, GM_CHUNK)
    n = T // rows
    mask = jnp.tril(jnp.ones((GM_CHUNK, GM_CHUNK), w_s.dtype))
    ws = (w_s * mask)[:, :rows, :rows]
    vr = v.reshape(B, n, rows, GM_GROUPS, GM_GROUP_DIM)
    s = jnp.einsum('gij,bnjgc->bnigc', ws, vr) + b_s[:, :rows].T[None, None, :, :, None]
    return u * s.reshape(B, T, GM_WIDTH)


def mixer_inputs(h, w_in, gm_ln_g, gm_ln_b):
    z = h @ w_in
    parts = []
    off = 0
    for w in IN_SPLITS:
        parts.append(z[..., off:off + w])
        off += w
    q, k, v, qi, ki, wi, zg, ga, gb = parts
    B, T = h.shape[:2]
    q = q.reshape(B, T, N_HEADS, HEAD_DIM)
    k = k.reshape(B, T, KV_HEADS, HEAD_DIM)
    v = v.reshape(B, T, KV_HEADS, HEAD_DIM)
    qi = qi.reshape(B, T, IDX_HEADS, IDX_DIM)
    zg = jax.nn.gelu(zg)
    u = zg[..., :GM_WIDTH]
    vg = layer_norm(zg[..., GM_WIDTH:], gm_ln_g, gm_ln_b)
    return q, k, v, qi, ki, wi, u, vg, ga, gb


def run_layer(x, mixer, ln1_g, ln1_b, f1g, f1u, f1d, w_in, gm_ln_g, gm_ln_b, gm_ws, gm_bs,
              w_br_a, w_br_b, w_out, ln2_g, ln2_b, f2g, f2u, f2d, ln3_g, ln3_b):
    h = layer_norm(ALPHA * x + 0.5 * swiglu(x, f1g, f1u, f1d), ln1_g, ln1_b)
    q, k, v, qi, ki, wi, u, vg, ga, gb = mixer_inputs(h, w_in, gm_ln_g, gm_ln_b)
    a, rows = mixer(q, k, v, qi, ki, wi)
    g = spatial_gate(u, vg, gm_ws, gm_bs)
    mixed = (jax.nn.sigmoid(ga) * (a @ w_br_a) + jax.nn.sigmoid(gb) * (g @ w_br_b)) @ w_out
    h = layer_norm(ALPHA * h + mixed, ln2_g, ln2_b)
    y = layer_norm(ALPHA * h + 0.5 * swiglu(h, f2g, f2u, f2d), ln3_g, ln3_b)
    return y, rows, vg


def setup_inputs(seed: int = 0) -> dict:
    key = jax.random.key(seed)
    ks = iter(jax.random.split(key, 32))

    def nrm(shape, scale):
        return jax.random.normal(next(ks), shape, jnp.float32) * scale

    col_scale = jnp.ones((IN_WIDTH,), jnp.float32).at[ATT_Q + ATT_KV:ATT_Q + 2 * ATT_KV].set(BETA)
    return {
        "x_prompt": nrm((BATCH, SEQ, D_MODEL), 1.0),
        "x_sample": nrm((DEC_BATCH, DEC_SEQ, D_MODEL), 1.0),
        "cache_k": nrm((DEPTH, DEC_BATCH, PAST_LEN, KV_HEADS, HEAD_DIM), 1.0),
        "cache_v": nrm((DEPTH, DEC_BATCH, PAST_LEN, KV_HEADS, HEAD_DIM), BETA),
        "cache_kidx": nrm((DEPTH, DEC_BATCH, PAST_LEN, IDX_DIM), 1.0),
        "rel_table": nrm((REL_BUCKETS, N_HEADS), 0.5),
        "ln1_g": 1.0 + nrm((DEPTH, D_MODEL), 0.02),
        "ln1_b": nrm((DEPTH, D_MODEL), 0.02),
        "ffn1_wg": nrm((DEPTH, D_MODEL, D_FF), D_MODEL ** -0.5),
        "ffn1_wu": nrm((DEPTH, D_MODEL, D_FF), D_MODEL ** -0.5),
        "ffn1_wd": nrm((DEPTH, D_FF, D_MODEL), D_FF ** -0.5 * BETA),
        "w_in": nrm((DEPTH, D_MODEL, IN_WIDTH), D_MODEL ** -0.5) * col_scale,
        "gm_ln_g": 1.0 + nrm((DEPTH, GM_WIDTH), 0.02),
        "gm_ln_b": nrm((DEPTH, GM_WIDTH), 0.02),
        "gm_ws": nrm((DEPTH, GM_GROUPS, GM_CHUNK, GM_CHUNK), GM_CHUNK ** -0.5),
        "gm_bs": 1.0 + nrm((DEPTH, GM_GROUPS, GM_CHUNK), 0.02),
        "w_br_a": nrm((DEPTH, ATT_Q, D_MODEL), ATT_Q ** -0.5 * BETA),
        "w_br_b": nrm((DEPTH, GM_WIDTH, D_MODEL), GM_WIDTH ** -0.5 * BETA),
        "w_out": nrm((DEPTH, D_MODEL, D_MODEL), D_MODEL ** -0.5 * BETA),
        "ln2_g": 1.0 + nrm((DEPTH, D_MODEL), 0.02),
        "ln2_b": nrm((DEPTH, D_MODEL), 0.02),
        "ffn2_wg": nrm((DEPTH, D_MODEL, D_FF), D_MODEL ** -0.5),
        "ffn2_wu": nrm((DEPTH, D_MODEL, D_FF), D_MODEL ** -0.5),
        "ffn2_wd": nrm((DEPTH, D_FF, D_MODEL), D_FF ** -0.5 * BETA),
        "ln3_g": 1.0 + nrm((DEPTH, D_MODEL), 0.02),
        "ln3_b": nrm((DEPTH, D_MODEL), 0.02),
    }


def reference(x_prompt, x_sample, cache_k, cache_v, cache_kidx, rel_table,
              ln1_g, ln1_b, ffn1_wg, ffn1_wu, ffn1_wd, w_in, gm_ln_g, gm_ln_b, gm_ws, gm_bs,
              w_br_a, w_br_b, w_out, ln2_g, ln2_b, ffn2_wg, ffn2_wu, ffn2_wd, ln3_g, ln3_b):
    past = cache_k.shape[2]
    n_new = x_sample.shape[1]
    total = past + n_new
    n_sel_sample = min(TOPK_MAX, total // 4)
    pos_s = past + jnp.arange(n_new, dtype=jnp.int32)
    vis_s = jnp.full((n_new,), total, jnp.int32)

    xp, xs = x_prompt, x_sample
    kp_l, vp_l, kip_l, ks_l, vs_l, kis_l, gv_l = [], [], [], [], [], [], []
    for l in range(DEPTH):
        lw = (ln1_g[l], ln1_b[l], ffn1_wg[l], ffn1_wu[l], ffn1_wd[l], w_in[l], gm_ln_g[l], gm_ln_b[l],
              gm_ws[l], gm_bs[l], w_br_a[l], w_br_b[l], w_out[l], ln2_g[l], ln2_b[l],
              ffn2_wg[l], ffn2_wu[l], ffn2_wd[l], ln3_g[l], ln3_b[l])

        def prompt_mixer(q, k, v, qi, ki, wi):
            return dsa_prompt(q, qi, wi, k, v, ki, rel_table), (k, v, ki)

        def sample_mixer(q, k, v, qi, ki, wi, l=l):
            k_all = jnp.concatenate([cache_k[l].astype(k.dtype), k], axis=1)
            v_all = jnp.concatenate([cache_v[l].astype(v.dtype), v], axis=1)
            ki_all = jnp.concatenate([cache_kidx[l].astype(ki.dtype), ki], axis=1)
            a = dsa_attend(q, qi, wi, pos_s, vis_s, k_all, v_all, ki_all, rel_table, n_sel_sample)
            return a, (k, v, ki)

        xp, (kp, vp, kip), _ = run_layer(xp, prompt_mixer, *lw)
        xs, (ks_, vs_, kis), gv = run_layer(xs, sample_mixer, *lw)
        kp_l.append(kp); vp_l.append(vp); kip_l.append(kip)
        ks_l.append(ks_); vs_l.append(vs_); kis_l.append(kis); gv_l.append(gv)

    return (xp, xs, jnp.stack(kp_l), jnp.stack(vp_l), jnp.stack(kip_l),
            jnp.stack(ks_l), jnp.stack(vs_l), jnp.stack(kis_l), jnp.stack(gv_l))
```

```cpp
#include <hip/hip_runtime.h>
#include <hip/hip_cooperative_groups.h>
#include <cstdio>
#include <cstdint>
namespace cg = cooperative_groups;

constexpr int MP = 65536, MS = 512, MT = MP + MS, DM = 1024, FF = 2816, NUP = 2 * FF, NWIN = 6400, WIN_SRC = 6216;
constexpr int SEQ = 8192, LTOT = 1040;
constexpr float LN_EPS = 1e-5f;
constexpr int NWAVES = 8, NTHREADS = 512;
constexpr int LDS_BYTES = 163840;
constexpr size_t O_YP = 0, O_YS = (size_t)MP * 1024, O_KP = O_YS + (size_t)MS * 1024, O_VP = O_KP + (size_t)MP * 256, O_KIP = O_VP + (size_t)MP * 256,
                 O_KS = O_KIP + (size_t)MP * 64, O_VS = O_KS + (size_t)MS * 256, O_KIS = O_VS + (size_t)MS * 256, O_GV = O_KIS + (size_t)MS * 64, O_END = O_GV + (size_t)MS * 1024;
constexpr size_t MiB = 1u << 20;
constexpr size_t WS_BAR = 64 * 1024;
constexpr size_t WS_W1U = 1 * MiB, WS_W1D = 12 * MiB, WS_W2U = 18 * MiB, WS_W2D = 29 * MiB, WS_WIN = 35 * MiB, WS_WA = 48 * MiB, WS_WB = 50 * MiB, WS_WO = 52 * MiB, WS_WGM = 54 * MiB;
constexpr size_t WS_KS = 55 * MiB, WS_VS = 72 * MiB, WS_KIS = 89 * MiB;
constexpr size_t WS_XB = 104 * MiB, WS_H1 = 233 * MiB, WS_HID = 362 * MiB;
constexpr size_t WS_Q = 362 * MiB, WS_U = 491 * MiB, WS_VPRE = 620 * MiB, WS_QI = 749 * MiB, WS_KP = 814 * MiB, WS_VP = 846 * MiB, WS_KIP = 878 * MiB, WS_WI = 886 * MiB, WS_SEL = 890 * MiB, WS_END = 956 * MiB;
constexpr size_t WS_PRE1 = WS_SEL, WS_PRE2 = WS_Q, WS_PRE3 = WS_H1;
static_assert(WS_SEL + (size_t)MT * 1024 * 2 <= 1024 * MiB, "pre1 fits the workspace");
static_assert((size_t)MT * 1024 * 2 <= 129 * MiB && (size_t)MT * FF * 2 <= 355 * MiB && (size_t)MT * 512 * 2 <= 65 * MiB, "ws map");


namespace pg8 {
#define PG8_LAS __attribute__((address_space(3)))
typedef unsigned short bf16_t;
typedef short bf16x8 __attribute__((ext_vector_type(8)));
typedef float f32x4 __attribute__((ext_vector_type(4)));
typedef unsigned u32x4 __attribute__((ext_vector_type(4)));
constexpr int BM = 256, BK = 64, HALF = 128, HTB = HALF * BK * 2  , STAGE_BYTES = 8 * HTB, NXCD = 8, WGM = 4;

__host__ __device__ __forceinline__ int lds_byte(int r, int c) { const int st = (r >> 4) * 2 + (c >> 5), rr = r & 15, cc = c & 31, ob = rr * 64 + cc * 2; return st * 1024 + (ob ^ (((ob >> 9) & 1) << 5)); }
__host__ __device__ __forceinline__ void stage_rc(int b, int& R, int& C) { const int st = b / 1024, sb = b % 1024, swz = sb ^ (((sb >> 9) & 1) << 5); R = (st >> 1) * 16 + swz / 64; C = (st & 1) * 32 + (swz % 64) / 2; }
__host__ __device__ __forceinline__ int perm32(int rho) { const int n = rho >> 4, i = rho & 15; return 8 * (i >> 2) + 4 * n + (i & 3); }

struct Unit { int pm, pn; };
struct Gemm { const bf16_t* A; const bf16_t* Bt; int M, N, K; };

struct StaticOrder {
    int nM, nN, nwg, G, c;
    __host__ __device__ void init(int M, int N, int G_, int c_) { nM = M / BM; nN = N / BM; nwg = nM * nN; G = G_; c = c_; }
    __host__ __device__ bool next(int i, Unit& u) const {
        const long L = (long)i * G + c; if (L >= nwg) return false;
        int wgid = (int)L; { const int q = nwg / NXCD, r = nwg % NXCD, xcd = wgid % NXCD, off = wgid / NXCD; wgid = (xcd < r ? xcd * (q + 1) : r * (q + 1) + (xcd - r) * q) + off; }
        const int nig = WGM * nN, gid = wgid / nig, fm = gid * WGM, gsz = (nM - fm) < WGM ? (nM - fm) : WGM;
        u.pm = fm + ((wgid % nig) % gsz); u.pn = (wgid % nig) / gsz; return true;
    }
    __device__ __forceinline__ void a_ready(const Unit&) const {}
    __device__ __forceinline__ void done(const Unit&) const {}
};

typedef float f32x2v __attribute__((ext_vector_type(2)));
typedef __bf16 bf16x2v __attribute__((ext_vector_type(2)));
__device__ __forceinline__ unsigned pkbf(float lo, float hi) { f32x2v v = {lo, hi}; bf16x2v b = __builtin_convertvector(v, bf16x2v); return __builtin_bit_cast(unsigned, b); }
__device__ __forceinline__ float bflo(unsigned w) { return __uint_as_float(w << 16); }
__device__ __forceinline__ float bfhi(unsigned w) { return __uint_as_float(w & 0xffff0000u); }
__device__ __forceinline__ float fsigmoid(float x) { return __builtin_amdgcn_rcpf(1.0f + __expf(-x)); }
__device__ __forceinline__ float fgelu(float x) { const float t = 1.5957691216057308f * (x + 0.044715f * x * x * x); return x * fsigmoid(t); }
constexpr int E_MP = MP;
constexpr float E_ALPHA = 1.189207115002721f;

struct EpiUp {
    static constexpr bool PERM = true, AFTER_DRAIN = false;
    bf16_t* O;
    __device__ __forceinline__ void operator()(const f32x4 (&acc)[2][2][4][2], const Unit& u, int wr, int wc, int fr, int fq) const {
        const int row0 = u.pm * BM + wr * 64 + fr, col0 = u.pn * 128 + wc * 32 + 8 * fq;
#pragma unroll
        for (int ai = 0; ai < 2; ++ai)
#pragma unroll
            for (int m = 0; m < 4; ++m) {
                float h[8];
#pragma unroll
                for (int n = 0; n < 2; ++n)
#pragma unroll
                    for (int e = 0; e < 4; ++e) { const float g = acc[ai][0][m][n][e], up = acc[ai][1][m][n][e]; h[4 * n + e] = g * fsigmoid(g) * up; }
                u32x4 w; w.x = pkbf(h[0], h[1]); w.y = pkbf(h[2], h[3]); w.z = pkbf(h[4], h[5]); w.w = pkbf(h[6], h[7]);
                *(u32x4*)(O + (size_t)(row0 + ai * HALF + m * 16) * 2816 + col0) = w;
            }
    }
};
struct EpiDown {
    static constexpr bool PERM = true, AFTER_DRAIN = false;
    bf16_t* out; const float* xp; const float* xs; const bf16_t* resb; float scale;
    __device__ __forceinline__ void operator()(const f32x4 (&acc)[2][2][4][2], const Unit& u, int wr, int wc, int fr, int fq) const {
        const int row0 = u.pm * BM + wr * 64 + fr, col0 = u.pn * BM + wc * 32 + 8 * fq;
#pragma unroll
        for (int ai = 0; ai < 2; ++ai) {
            if (resb) {
                u32x4 rw[4][2];
#pragma unroll
                for (int m = 0; m < 4; ++m)
#pragma unroll
                    for (int bj = 0; bj < 2; ++bj) rw[m][bj] = *(const u32x4*)(resb + (size_t)(row0 + ai * HALF + m * 16) * 1024 + col0 + bj * HALF);
#pragma unroll
                for (int m = 0; m < 4; ++m)
#pragma unroll
                    for (int bj = 0; bj < 2; ++bj) { const u32x4 w0 = rw[m][bj];
                        const f32x4 r0 = (f32x4){bflo(w0.x), bfhi(w0.x), bflo(w0.y), bfhi(w0.y)}, r1 = (f32x4){bflo(w0.z), bfhi(w0.z), bflo(w0.w), bfhi(w0.w)};
                        const f32x4 o0 = r0 * E_ALPHA + acc[ai][bj][m][0] * scale, o1 = r1 * E_ALPHA + acc[ai][bj][m][1] * scale;
                        u32x4 w; w.x = pkbf(o0[0], o0[1]); w.y = pkbf(o0[2], o0[3]); w.z = pkbf(o1[0], o1[1]); w.w = pkbf(o1[2], o1[3]);
                        *(u32x4*)(out + (size_t)(row0 + ai * HALF + m * 16) * 1024 + col0 + bj * HALF) = w; }
                asm volatile("" ::: "memory");
            } else {
#pragma unroll
                for (int m = 0; m < 4; m += 2) {
                    f32x4 rf[2][2][2];
#pragma unroll
                    for (int mm = 0; mm < 2; ++mm) { const int row = row0 + ai * HALF + (m + mm) * 16;
                        const float* rp = (row < E_MP ? xp + (size_t)row * 1024 : xs + (size_t)(row - E_MP) * 1024) + col0;
#pragma unroll
                        for (int bj = 0; bj < 2; ++bj) { rf[mm][bj][0] = *(const f32x4*)(rp + bj * HALF); rf[mm][bj][1] = *(const f32x4*)(rp + bj * HALF + 4); } }
#pragma unroll
                    for (int mm = 0; mm < 2; ++mm)
#pragma unroll
                        for (int bj = 0; bj < 2; ++bj) { const f32x4 o0 = rf[mm][bj][0] * E_ALPHA + acc[ai][bj][m + mm][0] * scale, o1 = rf[mm][bj][1] * E_ALPHA + acc[ai][bj][m + mm][1] * scale;
                            u32x4 w; w.x = pkbf(o0[0], o0[1]); w.y = pkbf(o0[2], o0[3]); w.z = pkbf(o1[0], o1[1]); w.w = pkbf(o1[2], o1[3]);
                            *(u32x4*)(out + (size_t)(row0 + ai * HALF + (m + mm) * 16) * 1024 + col0 + bj * HALF) = w; }
                    asm volatile("" ::: "memory");
                }
            }
        }
    }
};
struct EpiBr {
    static constexpr bool PERM = true, AFTER_DRAIN = false;
    bf16_t* mb; const bf16_t* gate; int mode;
    __device__ __forceinline__ void operator()(const f32x4 (&acc)[2][2][4][2], const Unit& u, int wr, int wc, int fr, int fq) const {
        const int row0 = u.pm * BM + wr * 64 + fr, col0 = u.pn * BM + wc * 32 + 8 * fq;
#pragma unroll
        for (int ai = 0; ai < 2; ++ai) {
            u32x4 gw[4][2], pw[4][2];
#pragma unroll
            for (int m = 0; m < 4; ++m)
#pragma unroll
                for (int bj = 0; bj < 2; ++bj) { const size_t off = (size_t)(row0 + ai * HALF + m * 16) * 1024 + col0 + bj * HALF;
                    gw[m][bj] = *(const u32x4*)(gate + off); pw[m][bj] = (u32x4){0u, 0u, 0u, 0u}; if (mode) pw[m][bj] = *(const u32x4*)(mb + off); }
#pragma unroll
            for (int m = 0; m < 4; ++m)
#pragma unroll
                for (int bj = 0; bj < 2; ++bj) { const size_t off = (size_t)(row0 + ai * HALF + m * 16) * 1024 + col0 + bj * HALF;
                    const u32x4 g = gw[m][bj], p = pw[m][bj];
                    float v[8];
                    v[0] = bflo(g.x) * acc[ai][bj][m][0][0] + bflo(p.x); v[1] = bfhi(g.x) * acc[ai][bj][m][0][1] + bfhi(p.x); v[2] = bflo(g.y) * acc[ai][bj][m][0][2] + bflo(p.y); v[3] = bfhi(g.y) * acc[ai][bj][m][0][3] + bfhi(p.y);
                    v[4] = bflo(g.z) * acc[ai][bj][m][1][0] + bflo(p.z); v[5] = bfhi(g.z) * acc[ai][bj][m][1][1] + bfhi(p.z); v[6] = bflo(g.w) * acc[ai][bj][m][1][2] + bflo(p.w); v[7] = bfhi(g.w) * acc[ai][bj][m][1][3] + bfhi(p.w);
                    u32x4 w; w.x = pkbf(v[0], v[1]); w.y = pkbf(v[2], v[3]); w.z = pkbf(v[4], v[5]); w.w = pkbf(v[6], v[7]);
                    *(u32x4*)(mb + off) = w; }
            asm volatile("" ::: "memory");
        }
    }
};
struct EpiWin {
    static constexpr bool PERM = true, AFTER_DRAIN = false;
    unsigned char* ws; float* out;
    __device__ __forceinline__ void operator()(const f32x4 (&acc)[2][2][4][2], const Unit& u, int wr, int wc, int fr, int fq) const {
        const int row0 = u.pm * BM + wr * 64 + fr, cw = wc * 32 + 8 * fq, pn = u.pn;
        int act = 0, pitch = 1024, ctile = 0; size_t bbase = 0; bool b_in_out = false;
        if (pn < 4) { bbase = WS_Q; ctile = pn * 256; }
        else if (pn < 6) { pitch = 256; }
        else if (pn < 8) { bbase = WS_QI; pitch = 512; ctile = (pn - 6) * 256; }
        else if (pn == 8) { pitch = 64; }
        else if (pn < 13) { bbase = WS_U; ctile = (pn - 9) * 256; act = 1; }
        else if (pn < 17) { bbase = WS_VPRE; ctile = (pn - 13) * 256; act = 1; }
        else if (pn < 21) { bbase = 0; b_in_out = true; ctile = (pn - 17) * 256; act = 2; }
        else { bbase = (size_t)MT * 1024 * 2; b_in_out = true; ctile = (pn - 21) * 256; act = 2; }
#pragma unroll
        for (int ai = 0; ai < 2; ++ai)
#pragma unroll
            for (int m = 0; m < 4; ++m) {
                const int row = row0 + ai * HALF + m * 16;
                const bool samp = row >= E_MP; const int rs = row - E_MP; const int srow = (rs >> 4) * 1040 + 1024 + (rs & 15);
#pragma unroll
                for (int bj = 0; bj < 2; ++bj) {
                    const int cc = cw + bj * HALF;
                    float v[8];
#pragma unroll
                    for (int e = 0; e < 4; ++e) { v[e] = acc[ai][bj][m][0][e]; v[4 + e] = acc[ai][bj][m][1][e]; }
                    if (act == 1) {
#pragma unroll
                        for (int e = 0; e < 8; ++e) v[e] = fgelu(v[e]); }
                    else if (act == 2) {
#pragma unroll
                        for (int e = 0; e < 8; ++e) v[e] = fsigmoid(v[e]); }
                    bf16_t* dst = nullptr; float* fo = nullptr;
                    if (pn == 4 || pn == 5) {
                        const size_t bo = samp ? (pn == 4 ? WS_KS : WS_VS) + ((size_t)srow * 256 + cc) * 2 : (pn == 4 ? WS_KP : WS_VP) + ((size_t)row * 256 + cc) * 2;
                        dst = (bf16_t*)(ws + bo);
                        fo = out + (samp ? (pn == 4 ? O_KS : O_VS) + (size_t)rs * 256 + cc : (pn == 4 ? O_KP : O_VP) + (size_t)row * 256 + cc);
                    } else if (pn == 8) {
                        if (cc < 64) { dst = (bf16_t*)(ws + (samp ? WS_KIS + ((size_t)srow * 64 + cc) * 2 : WS_KIP + ((size_t)row * 64 + cc) * 2));
                                       fo = out + (samp ? O_KIS + (size_t)rs * 64 + cc : O_KIP + (size_t)row * 64 + cc); }
                        else if (cc == 64) fo = (float*)(ws + WS_WI) + (size_t)row * 8;
                    } else {
                        const size_t bo = bbase + ((size_t)row * pitch + ctile + cc) * 2;
                        dst = (bf16_t*)((b_in_out ? (unsigned char*)out : ws) + bo);
                    }
                    if (fo) { *(f32x4*)fo = (f32x4){v[0], v[1], v[2], v[3]}; *(f32x4*)(fo + 4) = (f32x4){v[4], v[5], v[6], v[7]}; }
                    if (dst) { u32x4 w; w.x = pkbf(v[0], v[1]); w.y = pkbf(v[2], v[3]); w.z = pkbf(v[4], v[5]); w.w = pkbf(v[6], v[7]); *(u32x4*)dst = w; }
                }
                asm volatile("" ::: "memory");
            }
    }
};

template <class Epi, class Sched, bool ALIGN_EPI = false, bool SP2 = false>
__device__ __forceinline__ void gemm_phase(PG8_LAS unsigned char* lds, const Gemm g, const Sched& S, const Epi& E) {
    int tid_ = threadIdx.x; asm volatile("" : "+v"(tid_)); const int tid = tid_, wid = __builtin_amdgcn_readfirstlane(tid >> 6), lane = tid & 63, wr = wid >> 2, wc = wid & 3, fr = lane & 15, fq = lane >> 4;
    const int K = g.K, nt = K / BK;
    unsigned voffA[2], voffB[2];
#pragma unroll
    for (int i = 0; i < 2; ++i) { int R, C; stage_rc(tid * 16 + i * 8192, R, C); const int Rb = Epi::PERM ? ((R & ~31) + perm32(R & 31)) : R;
        voffA[i] = (unsigned)(R * K + C) * 2u; voffB[i] = (unsigned)(Rb * K + C) * 2u; }
    const size_t kstep = (size_t)(BK * 2);
    const size_t hstep = (size_t)HALF * K * 2;
    const size_t tstep = 2 * hstep;
    const unsigned ldsw = (unsigned)wid * 1024u;
    const int aoff = lds_byte(wr * 64 + fr, fq * 8), boff = lds_byte(wc * 32 + fr, fq * 8);
#define PG8_SA(b, h) (((b) * 2 + (h)) * HTB)
#define PG8_SB(b, h) ((4 + (b) * 2 + (h)) * HTB)
#define PG8_STAGE(bufoff, gbase, voff) do { _Pragma("unroll") for (int _i = 0; _i < 2; ++_i) \
        __builtin_amdgcn_global_load_lds((const unsigned*)((const char*)(gbase) + (voff)[_i]), (PG8_LAS unsigned*)(lds + (bufoff) + ldsw + _i * 8192), 16, 0, 0); } while (0)
#define PG8_LDA(dst, b, h) do { _Pragma("unroll") for (int m = 0; m < 4; ++m) _Pragma("unroll") for (int k = 0; k < 2; ++k) dst[m][k] = *(const PG8_LAS bf16x8*)(lds + PG8_SA(b, h) + aoff + m * 2048 + k * 1024); } while (0)
#define PG8_LDB(dst, b, h) do { _Pragma("unroll") for (int n = 0; n < 2; ++n) _Pragma("unroll") for (int k = 0; k < 2; ++k) dst[n][k] = *(const PG8_LAS bf16x8*)(lds + PG8_SB(b, h) + boff + n * 2048 + k * 1024); } while (0)
#define PG8_MMA(ai, bj, At, Bt) do { __builtin_amdgcn_s_setprio(1); _Pragma("unroll") for (int m = 0; m < 4; ++m) _Pragma("unroll") for (int n = 0; n < 2; ++n) _Pragma("unroll") for (int k = 0; k < 2; ++k) \
        acc[ai][bj][m][n] = __builtin_amdgcn_mfma_f32_16x16x32_bf16(Bt[n][k], At[m][k], acc[ai][bj][m][n], 0, 0, 0); __builtin_amdgcn_s_setprio(0); } while (0)
#define PG8_WAIT_V(n) asm volatile("s_waitcnt vmcnt(" #n ")" ::: "memory")
#define PG8_WAIT_L(n) asm volatile("s_waitcnt lgkmcnt(" #n ")" ::: "memory")
#define PG8_BAR __builtin_amdgcn_s_barrier()
#define PG8_SCHED __builtin_amdgcn_sched_barrier(0)
    Unit cur, nxt; int ui = 0;
    if (!S.next(0, cur)) return;
    f32x4 acc[2][2][4][2];
#pragma unroll
    for (int a = 0; a < 2; ++a)
#pragma unroll
        for (int b = 0; b < 2; ++b)
#pragma unroll
            for (int m = 0; m < 4; ++m)
#pragma unroll
                for (int n = 0; n < 2; ++n) acc[a][b][m][n] = (f32x4){0.f, 0.f, 0.f, 0.f};
    bf16x8 At[4][2], B0[2][2], B1[2][2];
    const char* cA = (const char*)g.A + (size_t)cur.pm * tstep; const char* cB = (const char*)g.Bt + (size_t)cur.pn * tstep;
    S.a_ready(cur);
    if constexpr (SP2) {
        PG8_STAGE(PG8_SB(0, 0), cB, voffB); PG8_STAGE(PG8_SB(0, 1), cB + hstep, voffB); PG8_STAGE(PG8_SA(0, 0), cA, voffA); PG8_STAGE(PG8_SA(0, 1), cA + hstep, voffA);
        if (wr == 1) PG8_BAR;
        PG8_WAIT_V(2); PG8_BAR;
        PG8_STAGE(PG8_SB(1, 0), cB + kstep, voffB); PG8_STAGE(PG8_SA(1, 0), cA + kstep, voffA); PG8_STAGE(PG8_SB(1, 1), cB + hstep + kstep, voffB);
        PG8_WAIT_V(6); PG8_BAR;
    } else {
        PG8_STAGE(PG8_SB(0, 0), cB, voffB); PG8_STAGE(PG8_SA(0, 0), cA, voffA); PG8_STAGE(PG8_SB(0, 1), cB + hstep, voffB); PG8_STAGE(PG8_SA(0, 1), cA + hstep, voffA);
        if (wr == 1) PG8_BAR;
        PG8_WAIT_V(4); PG8_BAR;
        PG8_STAGE(PG8_SB(1, 0), cB + kstep, voffB); PG8_STAGE(PG8_SA(1, 0), cA + kstep, voffA); PG8_STAGE(PG8_SB(1, 1), cB + hstep + kstep, voffB);
        PG8_WAIT_V(6); PG8_BAR;
    }
    for (;;) {
        const bool has_next = S.next(ui + 1, nxt);
        const char* nA = has_next ? (const char*)g.A + (size_t)nxt.pm * tstep : cA; const char* nB = has_next ? (const char*)g.Bt + (size_t)nxt.pn * tstep : cB;
        for (int t = 0; t < nt; t += 2) {
            const bool last = (t == nt - 2);
            const char* a1 = cA + (size_t)(t + 1) * kstep;
            const char* a2 = last ? nA : cA + (size_t)(t + 2) * kstep; const char* b2 = last ? nB : cB + (size_t)(t + 2) * kstep;
            const char* a3 = a2 + kstep; const char* b3 = b2 + kstep;
            if (last && has_next) S.a_ready(nxt);
            if constexpr (SP2) {
            PG8_LDB(B0, 0, 0); PG8_LDB(B1, 0, 1); PG8_SCHED; PG8_LDA(At, 0, 0); PG8_STAGE(PG8_SA(1, 1), a1 + hstep, voffA);
            PG8_WAIT_V(8); PG8_WAIT_L(0); PG8_BAR; PG8_MMA(0, 0, At, B0); PG8_MMA(0, 1, At, B1); PG8_BAR; PG8_SCHED;
            PG8_LDA(At, 0, 1); PG8_STAGE(PG8_SB(0, 0), b2, voffB); PG8_STAGE(PG8_SB(0, 1), b2 + hstep, voffB); PG8_STAGE(PG8_SA(0, 0), a2, voffA);
            PG8_WAIT_V(8); PG8_WAIT_L(0); PG8_BAR; PG8_MMA(1, 0, At, B0); PG8_MMA(1, 1, At, B1); PG8_BAR; PG8_SCHED;
            PG8_LDB(B0, 1, 0); PG8_LDB(B1, 1, 1); PG8_SCHED; PG8_LDA(At, 1, 0); PG8_STAGE(PG8_SA(0, 1), a2 + hstep, voffA);
            PG8_WAIT_V(8); PG8_WAIT_L(0); PG8_BAR; PG8_MMA(0, 0, At, B0); PG8_MMA(0, 1, At, B1); PG8_BAR; PG8_SCHED;
            PG8_LDA(At, 1, 1); PG8_STAGE(PG8_SB(1, 0), b3, voffB); PG8_STAGE(PG8_SB(1, 1), b3 + hstep, voffB); PG8_STAGE(PG8_SA(1, 0), a3, voffA);
            PG8_WAIT_V(8); PG8_WAIT_L(0); PG8_BAR; PG8_MMA(1, 0, At, B0); PG8_MMA(1, 1, At, B1); PG8_BAR; PG8_SCHED;
            } else {
            PG8_LDB(B0, 0, 0); PG8_SCHED; PG8_LDA(At, 0, 0); PG8_STAGE(PG8_SA(1, 1), a1 + hstep, voffA);
            PG8_WAIT_L(8); PG8_BAR; PG8_WAIT_L(0); PG8_MMA(0, 0, At, B0); PG8_BAR; PG8_SCHED;
            PG8_LDB(B1, 0, 1); PG8_STAGE(PG8_SB(0, 0), b2, voffB);
            PG8_BAR; PG8_WAIT_L(0); PG8_MMA(0, 1, At, B1); PG8_BAR;
            PG8_LDA(At, 0, 1); PG8_STAGE(PG8_SA(0, 0), a2, voffA);
            PG8_BAR; PG8_WAIT_L(0); PG8_MMA(1, 0, At, B0); PG8_BAR; PG8_SCHED;
            PG8_STAGE(PG8_SB(0, 1), b2 + hstep, voffB);
            PG8_WAIT_V(6); PG8_BAR; PG8_MMA(1, 1, At, B1); PG8_BAR;
            PG8_LDB(B0, 1, 0); PG8_SCHED; PG8_LDA(At, 1, 0); PG8_STAGE(PG8_SA(0, 1), a2 + hstep, voffA);
            PG8_WAIT_L(8); PG8_BAR; PG8_WAIT_L(0); PG8_MMA(0, 0, At, B0); PG8_BAR; PG8_SCHED;
            PG8_LDB(B1, 1, 1); PG8_STAGE(PG8_SB(1, 0), b3, voffB);
            PG8_BAR; PG8_WAIT_L(0); PG8_MMA(0, 1, At, B1); PG8_BAR;
            PG8_LDA(At, 1, 1); PG8_STAGE(PG8_SA(1, 0), a3, voffA);
            PG8_BAR; PG8_WAIT_L(0); PG8_MMA(1, 0, At, B0); PG8_BAR; PG8_SCHED;
            PG8_STAGE(PG8_SB(1, 1), b3 + hstep, voffB);
            PG8_WAIT_V(6); PG8_BAR; PG8_MMA(1, 1, At, B1); PG8_BAR;
            }
        }
        if constexpr (ALIGN_EPI) { if (wr == 0) PG8_BAR; }
        if constexpr (!Epi::AFTER_DRAIN) { E(acc, cur, wr, wc, fr, fq); S.done(cur); }
        if (!has_next) break;
#pragma unroll
        for (int a = 0; a < 2; ++a)
#pragma unroll
            for (int b = 0; b < 2; ++b)
#pragma unroll
                for (int m = 0; m < 4; ++m)
#pragma unroll
                    for (int n = 0; n < 2; ++n) acc[a][b][m][n] = (f32x4){0.f, 0.f, 0.f, 0.f};
        cur = nxt; cA = nA; cB = nB; ++ui;
        if constexpr (ALIGN_EPI) { if (wr == 1) PG8_BAR; }
    }
    PG8_WAIT_V(0);
    if constexpr (!ALIGN_EPI) { if (wr == 0) PG8_BAR; }
    PG8_BAR;
    if constexpr (Epi::AFTER_DRAIN) { E.fused(acc, cur, wr, wc, fr, fq, lds, wid, lane); S.done(cur); }
#undef PG8_SA
#undef PG8_SB
#undef PG8_STAGE
#undef PG8_LDA
#undef PG8_LDB
#undef PG8_MMA
#undef PG8_WAIT_V
#undef PG8_WAIT_L
#undef PG8_BAR
#undef PG8_SCHED
}
}

#define LAS __attribute__((address_space(3)))
typedef unsigned short bf16_t;
typedef short bf16x8 __attribute__((ext_vector_type(8)));
typedef short s16x4 __attribute__((ext_vector_type(4)));
typedef float f32x4 __attribute__((ext_vector_type(4)));
typedef float f32x16 __attribute__((ext_vector_type(16)));
typedef unsigned u32x4 __attribute__((ext_vector_type(4)));
typedef unsigned u32x2 __attribute__((ext_vector_type(2)));
using pg8::pkbf; using pg8::bflo; using pg8::bfhi;

struct Args { const float* in[26]; float* out; unsigned char* ws; };
typedef const __attribute__((address_space(4))) Args* ArgsP;

__device__ __forceinline__ float wave_sum(float v) {
#pragma unroll
    for (int o = 1; o < 64; o <<= 1) v += __shfl_xor(v, o);
    return v;
}
__device__ __forceinline__ int wave_sum_i(int v) {
    v += __builtin_amdgcn_update_dpp(0, v, 0x128, 0xf, 0xf, false);
    v += __builtin_amdgcn_update_dpp(0, v, 0x124, 0xf, 0xf, false);
    v += __builtin_amdgcn_update_dpp(0, v, 0x122, 0xf, 0xf, false);
    v += __builtin_amdgcn_update_dpp(0, v, 0x121, 0xf, 0xf, false);
    return __builtin_amdgcn_readlane(v, 0) + __builtin_amdgcn_readlane(v, 16) + __builtin_amdgcn_readlane(v, 32) + __builtin_amdgcn_readlane(v, 48);
}
__device__ __forceinline__ unsigned wave_or_u(unsigned v) {
    v |= (unsigned)__builtin_amdgcn_update_dpp(0, (int)v, 0x128, 0xf, 0xf, false);
    v |= (unsigned)__builtin_amdgcn_update_dpp(0, (int)v, 0x124, 0xf, 0xf, false);
    v |= (unsigned)__builtin_amdgcn_update_dpp(0, (int)v, 0x122, 0xf, 0xf, false);
    v |= (unsigned)__builtin_amdgcn_update_dpp(0, (int)v, 0x121, 0xf, 0xf, false);
    return (unsigned)(__builtin_amdgcn_readlane((int)v, 0) | __builtin_amdgcn_readlane((int)v, 16) | __builtin_amdgcn_readlane((int)v, 32) | __builtin_amdgcn_readlane((int)v, 48));
}
__device__ __forceinline__ void lds_wait() { asm volatile("s_waitcnt lgkmcnt(0)" ::: "memory"); }

__device__ __forceinline__ int rowmap(int mode, int n) {
    if (mode == 1) return 256 * (n >> 7) + (n & 127);
    if (mode == 2) return 256 * (n >> 7) + 128 + (n & 127);
    if (mode == 3) return n < 2120 ? n : n + 184;
    return n;
}
__device__ __forceinline__ void transpose_item(const float* W, int K, int N, bf16_t* WT, int mode, LAS float* scr, int item, int lane) {
    const int nblk = (N + 31) >> 5, kb = item / nblk, nb = item % nblk, k0 = 64 * kb, n0 = 32 * nb;
    { const int ch = lane & 7, nn = n0 + 4 * ch;
      f32x4 v[8];
#pragma unroll
      for (int i = 0; i < 8; ++i) { v[i] = (f32x4){0.f, 0.f, 0.f, 0.f}; if (nn < N) v[i] = *(const f32x4*)(W + (size_t)(k0 + 8 * i + (lane >> 3)) * N + nn); }
#pragma unroll
      for (int i = 0; i < 8; ++i) { LAS float* d = scr + (8 * i + (lane >> 3)) * 33 + 4 * ch; d[0] = v[i].x; d[1] = v[i].y; d[2] = v[i].z; d[3] = v[i].w; } }
    lds_wait();
    const int c = lane & 7;
#pragma unroll
    for (int j = 0; j < 4; ++j) { const int n = (lane >> 3) + 8 * j; const LAS float* s = scr + (8 * c) * 33 + n;
        u32x4 o; o.x = pkbf(s[0 * 33], s[1 * 33]); o.y = pkbf(s[2 * 33], s[3 * 33]); o.z = pkbf(s[4 * 33], s[5 * 33]); o.w = pkbf(s[6 * 33], s[7 * 33]);
        if (n0 + n < N) *(u32x4*)(WT + (size_t)rowmap(mode, n0 + n) * K + k0 + 8 * c) = o; }
    lds_wait();
}
__device__ __forceinline__ void cvt_row4(const float* src, bf16_t* dst) { const f32x4 v = *(const f32x4*)src; u32x2 w; w.x = pkbf(v.x, v.y); w.y = pkbf(v.z, v.w); *(u32x2*)dst = w; }

__device__ __forceinline__ void prologue(ArgsP a, LAS unsigned char* lds, int G) {
    int tid_ = threadIdx.x; asm volatile("" : "+v"(tid_)); const int tid = tid_, lane = tid & 63, wave = tid >> 6;
    const int gw = blockIdx.x * NWAVES + wave, NGW = G * NWAVES;
    LAS float* scr = (LAS float*)(lds + wave * 16384);
    unsigned char* ws = a->ws;
    constexpr int I_UP = 16 * 88, I_DN = 44 * 32, I_IN = 16 * 195, I_SQ = 16 * 32;
    constexpr int NITEMS = 4 * I_UP + 2 * I_DN + I_IN + 3 * I_SQ;
    for (int it = gw; it < NITEMS; it += NGW) {
        int r = it;
        if (r < I_UP) { transpose_item(a->in[8], 1024, FF, (bf16_t*)(ws + WS_W1U), 1, scr, r, lane); continue; } r -= I_UP;
        if (r < I_UP) { transpose_item(a->in[9], 1024, FF, (bf16_t*)(ws + WS_W1U), 2, scr, r, lane); continue; } r -= I_UP;
        if (r < I_UP) { transpose_item(a->in[21], 1024, FF, (bf16_t*)(ws + WS_W2U), 1, scr, r, lane); continue; } r -= I_UP;
        if (r < I_UP) { transpose_item(a->in[22], 1024, FF, (bf16_t*)(ws + WS_W2U), 2, scr, r, lane); continue; } r -= I_UP;
        if (r < I_DN) { transpose_item(a->in[10], FF, 1024, (bf16_t*)(ws + WS_W1D), 0, scr, r, lane); continue; } r -= I_DN;
        if (r < I_DN) { transpose_item(a->in[23], FF, 1024, (bf16_t*)(ws + WS_W2D), 0, scr, r, lane); continue; } r -= I_DN;
        if (r < I_IN) { transpose_item(a->in[11], 1024, WIN_SRC, (bf16_t*)(ws + WS_WIN), 3, scr, r, lane); continue; } r -= I_IN;
        if (r < I_SQ) { transpose_item(a->in[16], 1024, 1024, (bf16_t*)(ws + WS_WA), 0, scr, r, lane); continue; } r -= I_SQ;
        if (r < I_SQ) { transpose_item(a->in[17], 1024, 1024, (bf16_t*)(ws + WS_WB), 0, scr, r, lane); continue; } r -= I_SQ;
        transpose_item(a->in[18], 1024, 1024, (bf16_t*)(ws + WS_WO), 0, scr, r, lane);
    }
    bf16_t* xb = (bf16_t*)(ws + WS_XB);
    for (int m = gw; m < MT; m += NGW) {
        const float* src = m < MP ? a->in[0] + (size_t)m * 1024 : a->in[1] + (size_t)(m - MP) * 1024;
#pragma unroll
        for (int j = 0; j < 4; ++j) cvt_row4(src + 4 * lane + 256 * j, xb + (size_t)m * 1024 + 4 * lane + 256 * j);
    }
    bf16_t *ks = (bf16_t*)(ws + WS_KS), *vs = (bf16_t*)(ws + WS_VS), *kis = (bf16_t*)(ws + WS_KIS);
    for (int r = gw; r < 32 * 1024; r += NGW) { const int b = r >> 10, s = r & 1023; const size_t d = ((size_t)b * LTOT + s) * 256 + 4 * lane;
        cvt_row4(a->in[2] + (size_t)r * 256 + 4 * lane, ks + d); cvt_row4(a->in[3] + (size_t)r * 256 + 4 * lane, vs + d); }
    for (int r4 = gw; r4 < 32 * 1024 / 4; r4 += NGW) { const int r = 4 * r4 + (lane >> 4), b = r >> 10, s = r & 1023, c = 4 * (lane & 15);
        cvt_row4(a->in[4] + (size_t)r * 64 + c, kis + ((size_t)b * LTOT + s) * 64 + c); }
    const int gt = blockIdx.x * NTHREADS + tid, NGT = G * NTHREADS;
    bf16_t* wgm = (bf16_t*)(ws + WS_WGM);
    for (int idx = gt; idx < 4 * 128 * 128; idx += NGT) { const int i = (idx >> 7) & 127, j = idx & 127; const float v = j <= i ? a->in[14][idx] : 0.f; wgm[idx] = (bf16_t)(pkbf(v, 0.f) & 0xffffu); }
    u32x4* wz = (u32x4*)((bf16_t*)(ws + WS_WIN) + (size_t)2120 * 1024);
    for (int idx = gt; idx < 184 * 128; idx += NGT) wz[idx] = (u32x4){0u, 0u, 0u, 0u};
}

__device__ __forceinline__ void ln_phase(const bf16_t* in, const float* g, const float* b, bf16_t* ob, float* of, int G) {
    int tid_ = threadIdx.x; asm volatile("" : "+v"(tid_)); const int tid = tid_, lane = tid & 63, wave = tid >> 6;
    const int gw = blockIdx.x * NWAVES + wave, NGW = G * NWAVES;
    f32x4 gv[4], bv[4];
#pragma unroll
    for (int j = 0; j < 4; ++j) { gv[j] = *(const f32x4*)(g + 4 * lane + 256 * j); bv[j] = *(const f32x4*)(b + 4 * lane + 256 * j); }
    for (int m = gw; m < MT; m += NGW) {
        const bf16_t* xr = in + (size_t)m * 1024 + 4 * lane;
        f32x4 v[4]; float s = 0.f;
#pragma unroll
        for (int j = 0; j < 4; ++j) { const u32x2 w = *(const u32x2*)(xr + 256 * j); v[j] = (f32x4){bflo(w.x), bfhi(w.x), bflo(w.y), bfhi(w.y)}; s += (v[j].x + v[j].y) + (v[j].z + v[j].w); }
        const float mean = wave_sum(s) * (1.f / 1024.f); float s2 = 0.f;
#pragma unroll
        for (int j = 0; j < 4; ++j) { v[j] = v[j] - mean; s2 += (v[j].x * v[j].x + v[j].y * v[j].y) + (v[j].z * v[j].z + v[j].w * v[j].w); }
        const float rstd = 1.f / sqrtf(wave_sum(s2) * (1.f / 1024.f) + LN_EPS);
#pragma unroll
        for (int j = 0; j < 4; ++j) { const f32x4 o = v[j] * rstd * gv[j] + bv[j];
            if (ob) { u32x2 w; w.x = pkbf(o.x, o.y); w.y = pkbf(o.z, o.w); *(u32x2*)(ob + (size_t)m * 1024 + 4 * lane + 256 * j) = w; }
            if (of) *(f32x4*)(of + (size_t)m * 1024 + 4 * lane + 256 * j) = o; }
    }
}

typedef short v4i16_t __attribute__((ext_vector_type(4)));
__device__ __forceinline__ s16x4 tr_read(const LAS unsigned char* p) { return __builtin_bit_cast(s16x4, __builtin_amdgcn_ds_read_tr16_b64_v4i16((LAS v4i16_t*)p)); }
constexpr int GIMG_STRIDE = 544;
constexpr int LDS_AUX = 131072;

__device__ __forceinline__ void gate_unit(ArgsP a, LAS unsigned char* lds, int unit) {
    int tid_ = threadIdx.x; asm volatile("" : "+v"(tid_)); const int tid = tid_, lane = tid & 63, wave = __builtin_amdgcn_readfirstlane(tid >> 6);
    const bool samp = unit >= 512;
    const int m0 = samp ? MP + 16 * (unit - 512) : 128 * unit, nrows = samp ? 16 : 128;
    const bf16_t* vpre = (const bf16_t*)(a->ws + WS_VPRE); bf16_t* ub = (bf16_t*)(a->ws + WS_U); const bf16_t* wgm = (const bf16_t*)(a->ws + WS_WGM);
    const float *gmg = a->in[12], *gmb = a->in[13], *gbs = a->in[15];
    LAS float* ST = (LAS float*)(lds + LDS_AUX);
    for (int rr = 0; rr < 16; ++rr) { const int row = wave * 16 + rr;
        if (row < nrows) { const bf16_t* rp = vpre + (size_t)(m0 + row) * 1024 + 8 * lane;
            const u32x4 w0 = *(const u32x4*)rp, w1 = *(const u32x4*)(rp + 512);
            float x[16] = {bflo(w0.x), bfhi(w0.x), bflo(w0.y), bfhi(w0.y), bflo(w0.z), bfhi(w0.z), bflo(w0.w), bfhi(w0.w), bflo(w1.x), bfhi(w1.x), bflo(w1.y), bfhi(w1.y), bflo(w1.z), bfhi(w1.z), bflo(w1.w), bfhi(w1.w)};
            float s = 0.f;
#pragma unroll
            for (int e = 0; e < 16; ++e) s += x[e];
            const float mean = wave_sum(s) * (1.f / 1024.f); float s2 = 0.f;
#pragma unroll
            for (int e = 0; e < 16; ++e) { const float d = x[e] - mean; s2 += d * d; }
            const float rstd = 1.f / sqrtf(wave_sum(s2) * (1.f / 1024.f) + LN_EPS);
            if (lane == 0) { ST[2 * row] = mean; ST[2 * row + 1] = rstd; } } }
    __syncthreads();
    const int j16 = lane & 15, kq = lane >> 4;
    for (int g = 0; g < 4; ++g) {
        { const int col = 8 * (tid & 31);
          const f32x4 g0 = *(const f32x4*)(gmg + 256 * g + col), g1 = *(const f32x4*)(gmg + 256 * g + col + 4), b0 = *(const f32x4*)(gmb + 256 * g + col), b1 = *(const f32x4*)(gmb + 256 * g + col + 4);
          u32x4 xr[8];
#pragma unroll
          for (int it = 0; it < 8; ++it) { const int row = it * 16 + (tid >> 5); xr[it] = (u32x4){0u, 0u, 0u, 0u}; if (row < nrows) xr[it] = *(const u32x4*)(vpre + (size_t)(m0 + row) * 1024 + 256 * g + col); }
#pragma unroll
          for (int it = 0; it < 8; ++it) { const int row = it * 16 + (tid >> 5); const float mean = ST[2 * row], rstd = ST[2 * row + 1]; u32x4 w = (u32x4){0u, 0u, 0u, 0u};
              if (row < nrows) { const u32x4 x = xr[it];
                  f32x4 y0 = (f32x4){bflo(x.x), bfhi(x.x), bflo(x.y), bfhi(x.y)}, y1 = (f32x4){bflo(x.z), bfhi(x.z), bflo(x.w), bfhi(x.w)};
                  y0 = (y0 - mean) * rstd * g0 + b0; y1 = (y1 - mean) * rstd * g1 + b1;
                  w.x = pkbf(y0.x, y0.y); w.y = pkbf(y0.z, y0.w); w.z = pkbf(y1.x, y1.y); w.w = pkbf(y1.z, y1.w);
                  if (samp) { float* o = a->out + O_GV + (size_t)(m0 - MP + row) * 1024 + 256 * g + col; *(f32x4*)o = y0; *(f32x4*)(o + 4) = y1; } }
              *(LAS u32x4*)(lds + row * GIMG_STRIDE + col * 2) = w; } }
        __syncthreads();
        const int ib = 32 * (wave & 3), cb = 128 * (wave >> 2);
        f32x4 acc[2][8];
#pragma unroll
        for (int it = 0; it < 2; ++it)
#pragma unroll
            for (int ct = 0; ct < 8; ++ct) acc[it][ct] = (f32x4){0.f, 0.f, 0.f, 0.f};
#pragma unroll
        for (int ks = 0; ks < 4; ++ks) if (ks <= (wave & 3)) {
            bf16x8 wf[2];
#pragma unroll
            for (int it = 0; it < 2; ++it) wf[it] = *(const bf16x8*)(wgm + (size_t)g * 16384 + (ib + 16 * it + j16) * 128 + 32 * ks + 8 * kq);
#pragma unroll
            for (int ct = 0; ct < 8; ++ct) {
                const LAS unsigned char* p = lds + (32 * ks + 8 * kq + (j16 >> 2)) * GIMG_STRIDE + (cb + 16 * ct + 4 * (j16 & 3)) * 2;
                const s16x4 lo = tr_read(p), hi = tr_read(p + 4 * GIMG_STRIDE);
                const bf16x8 vf = (bf16x8){lo[0], lo[1], lo[2], lo[3], hi[0], hi[1], hi[2], hi[3]};
#pragma unroll
                for (int it = 0; it < 2; ++it) acc[it][ct] = __builtin_amdgcn_mfma_f32_16x16x32_bf16(vf, wf[it], acc[it][ct], 0, 0, 0);
            }
        }
#pragma unroll
        for (int it = 0; it < 2; ++it) { const int i = ib + 16 * it + j16;
            if (i < nrows) { const float bsv = gbs[g * 128 + i];
#pragma unroll
                for (int ct = 0; ct < 8; ++ct) { bf16_t* up = ub + (size_t)(m0 + i) * 1024 + 256 * g + cb + 16 * ct + 4 * kq;
                    const u32x2 uu = *(const u32x2*)up; const f32x4 s = acc[it][ct] + bsv; u32x2 w;
                    w.x = pkbf(bflo(uu.x) * s.x, bfhi(uu.x) * s.y); w.y = pkbf(bflo(uu.y) * s.z, bfhi(uu.y) * s.w); *(u32x2*)up = w; } } }
        __syncthreads();
    }
}

constexpr int VST_STRIDE = 288, VST_BYTES = 32 * VST_STRIDE;
__device__ __forceinline__ unsigned f2key(float f) { const unsigned u = __float_as_uint(f); return u ^ ((unsigned)((int)u >> 31) | 0x80000000u); }
__device__ __forceinline__ unsigned sel_entry(int s, int qpos) {
    const int rel = s - qpos, n = rel < 0 ? -rel : rel;
    const int large = 8 + (n >= 12) + (n >= 16) + (n >= 23) + (n >= 32) + (n >= 46) + (n >= 64) + (n >= 91);
    const int bk = (rel > 0 ? 16 : 0) + (n < 8 ? n : large);
    return (unsigned)s | ((unsigned)bk << 16) | (1u << 24);
}

#define TRANSPOSE32(K0) do { \
    _Pragma("unroll") for (int k = 0; k < 16; ++k) { const unsigned x = key[(K0) + k], y = key[(K0) + k + 16]; \
        key[(K0) + k] = __builtin_amdgcn_perm(y, x, 0x05040100u); key[(K0) + k + 16] = __builtin_amdgcn_perm(y, x, 0x07060302u); } \
    _Pragma("unroll") for (int k = 0; k < 32; ++k) if ((k & 8) == 0) { const unsigned x = key[(K0) + k], y = key[(K0) + k + 8]; \
        key[(K0) + k] = __builtin_amdgcn_perm(y, x, 0x06020400u); key[(K0) + k + 8] = __builtin_amdgcn_perm(y, x, 0x07030501u); } \
    _Pragma("unroll") for (int k = 0; k < 32; ++k) if ((k & 4) == 0) { const unsigned x = key[(K0) + k], y = key[(K0) + k + 4]; \
        key[(K0) + k] = (x & 0x0f0f0f0fu) | ((y << 4) & 0xf0f0f0f0u); key[(K0) + k + 4] = ((x >> 4) & 0x0f0f0f0fu) | (y & 0xf0f0f0f0u); } \
    _Pragma("unroll") for (int k = 0; k < 32; ++k) if ((k & 2) == 0) { const unsigned x = key[(K0) + k], y = key[(K0) + k + 2]; \
        key[(K0) + k] = (x & 0x33333333u) | ((y << 2) & 0xccccccccu); key[(K0) + k + 2] = ((x >> 2) & 0x33333333u) | (y & 0xccccccccu); } \
    _Pragma("unroll") for (int k = 0; k < 32; ++k) if ((k & 1) == 0) { const unsigned x = key[(K0) + k], y = key[(K0) + k + 1]; \
        key[(K0) + k] = (x & 0x55555555u) | ((y << 1) & 0xaaaaaaaau); key[(K0) + k + 1] = ((x >> 1) & 0x55555555u) | (y & 0xaaaaaaaau); } } while (0)

__device__ __forceinline__ void sel_unit(ArgsP a, LAS unsigned char* lds, int unit) {
    int tid_ = threadIdx.x; asm volatile("" : "+v"(tid_)); const int tid = tid_, lane = tid & 63, wave = __builtin_amdgcn_readfirstlane(tid >> 6);
    int m0, nvis, qpos0; const bf16_t* Kib;
    if (unit < 64) { const int b = unit >> 1, i0 = (unit & 1) * 8; m0 = MP + b * 16 + i0; nvis = LTOT; qpos0 = 1024 + i0; Kib = (const bf16_t*)(a->ws + WS_KIS) + (size_t)b * LTOT * 64; }
    else { const int u = unit - 64, b = u >> 10, t0 = (u & 1023) * 8; m0 = b * SEQ + t0; nvis = ((t0 >> 6) + 1) * 64; qpos0 = t0; Kib = (const bf16_t*)(a->ws + WS_KIP) + (size_t)b * SEQ * 64; }
    const bf16_t* qib = (const bf16_t*)(a->ws + WS_QI); const float* wib = (const float*)(a->ws + WS_WI);
    LAS float* SC = (LAS float*)lds;
    LAS unsigned* SEL = (LAS unsigned*)(lds + LDS_AUX);
    LAS unsigned* sel = SEL + wave * 256; const LAS float* sc = SC + wave * 4096; const int qpos = qpos0 + wave;
    const int j = lane & 15, kq = lane >> 4;
    unsigned key[128];

    bf16x8 af[2][2][2];
    { const int tq = j >> 2;
#pragma unroll
      for (int qg = 0; qg < 2; ++qg)
#pragma unroll
        for (int mt = 0; mt < 2; ++mt) { const int hh = 4 * mt + (j & 3); const size_t mq = (size_t)(m0 + 4 * qg + tq); const float wabs = fabsf(wib[mq * 8 + hh]);
#pragma unroll
          for (int ks = 0; ks < 2; ++ks) { const u32x4 w = *(const u32x4*)(qib + mq * 512 + hh * 64 + 32 * ks + 8 * kq);
              u32x4 o; o.x = pkbf(bflo(w.x) * wabs, bfhi(w.x) * wabs); o.y = pkbf(bflo(w.y) * wabs, bfhi(w.y) * wabs); o.z = pkbf(bflo(w.z) * wabs, bfhi(w.z) * wabs); o.w = pkbf(bflo(w.w) * wabs, bfhi(w.w) * wabs);
              af[qg][mt][ks] = __builtin_bit_cast(bf16x8, o); } } }
    float sg[2][8];
#pragma unroll
    for (int qg = 0; qg < 2; ++qg)
#pragma unroll
        for (int r4 = 0; r4 < 2; ++r4) { const f32x4 w = *(const f32x4*)(wib + (size_t)(m0 + 4 * qg + kq) * 8 + 4 * r4);
#pragma unroll
            for (int e = 0; e < 4; ++e) sg[qg][4 * r4 + e] = w[e] > 0.f ? 1.f : (w[e] < 0.f ? -1.f : 0.f); }

    LAS unsigned char* stg = lds + LDS_AUX + 8192 + wave * 2304;
#define SC_LOAD(dst, tile) do { const bf16_t* kp_ = Kib + (size_t)((tile) * 32 + (lane >> 3)) * 64 + 8 * (lane & 7); \
        dst[0] = *(const bf16x8*)kp_; dst[1] = *(const bf16x8*)(kp_ + 8 * 64); dst[2] = *(const bf16x8*)(kp_ + 16 * 64); dst[3] = *(const bf16x8*)(kp_ + 24 * 64); } while (0)
#define SC_TILE(src, tloc) do { _Pragma("unroll") for (int c = 0; c < 2; ++c) { \
        *(LAS bf16x8*)(stg + (lane >> 3) * 144 + (lane & 7) * 16) = src[2 * c]; *(LAS bf16x8*)(stg + (8 + (lane >> 3)) * 144 + (lane & 7) * 16) = src[2 * c + 1]; \
        asm volatile("" ::: "memory"); __builtin_amdgcn_wave_barrier(); \
        const bf16x8 f0 = *(const LAS bf16x8*)(stg + j * 144 + 16 * kq), f1 = *(const LAS bf16x8*)(stg + j * 144 + 64 + 16 * kq); \
        asm volatile("" ::: "memory"); __builtin_amdgcn_wave_barrier(); \
        _Pragma("unroll") for (int qg = 0; qg < 2; ++qg) { \
        f32x4 d0 = (f32x4){0.f, 0.f, 0.f, 0.f}, d1 = (f32x4){0.f, 0.f, 0.f, 0.f}; \
        d0 = __builtin_amdgcn_mfma_f32_16x16x32_bf16(af[qg][0][0], f0, d0, 0, 0, 0); d1 = __builtin_amdgcn_mfma_f32_16x16x32_bf16(af[qg][1][0], f0, d1, 0, 0, 0); \
        d0 = __builtin_amdgcn_mfma_f32_16x16x32_bf16(af[qg][0][1], f1, d0, 0, 0, 0); d1 = __builtin_amdgcn_mfma_f32_16x16x32_bf16(af[qg][1][1], f1, d1, 0, 0, 0); \
        float sa = 0.f, sb = 0.f; \
        _Pragma("unroll") for (int r = 0; r < 4; ++r) { sa += sg[qg][r] * fmaxf(d0[r], 0.f); sb += sg[qg][4 + r] * fmaxf(d1[r], 0.f); } \
        SC[(4 * qg + kq) * 4096 + (tloc) * 32 + 16 * c + j] = sa + sb; } } } while (0)
#pragma unroll
    for (int half = 0; half < 2; ++half) {
        if (half * 4096 < nvis) {
            const int khi = nvis < half * 4096 + 4096 ? nvis : half * 4096 + 4096, ntiles = (khi - half * 4096 + 31) >> 5, tbase = half * 128;
            bf16x8 b0[4], b1[4], b2[4], b3[4];
            const int nk = (ntiles - wave + NWAVES - 1) / NWAVES;
            if (nk > 0) {
#define TLOC(k) (wave + NWAVES * ((k) < nk ? (k) : nk - 1))
                SC_LOAD(b0, tbase + TLOC(0)); SC_LOAD(b1, tbase + TLOC(1)); SC_LOAD(b2, tbase + TLOC(2)); __builtin_amdgcn_sched_barrier(0);
                for (int k = 0; k < nk; k += 4) {
                    SC_LOAD(b3, tbase + TLOC(k + 3)); __builtin_amdgcn_sched_barrier(0);
                    SC_TILE(b0, TLOC(k)); __builtin_amdgcn_sched_barrier(0);
                    SC_LOAD(b0, tbase + TLOC(k + 4)); __builtin_amdgcn_sched_barrier(0);
                    if (k + 1 < nk) SC_TILE(b1, TLOC(k + 1));
                    __builtin_amdgcn_sched_barrier(0);
                    SC_LOAD(b1, tbase + TLOC(k + 5)); __builtin_amdgcn_sched_barrier(0);
                    if (k + 2 < nk) SC_TILE(b2, TLOC(k + 2));
                    __builtin_amdgcn_sched_barrier(0);
                    SC_LOAD(b2, tbase + TLOC(k + 6)); __builtin_amdgcn_sched_barrier(0);
                    if (k + 3 < nk) SC_TILE(b3, TLOC(k + 3));
                    __builtin_amdgcn_sched_barrier(0);
                }
#undef TLOC
            }
            __syncthreads();
            if (nvis > 256) {
#pragma unroll
                for (int wb = 0; wb < 2; ++wb) {
                    const int w = 2 * half + wb;
                    if (w * 2048 < nvis) {
#pragma unroll
                        for (int k = 0; k < 32; ++k) key[32 * w + k] = f2key(sc[(32 * wb + k) * 64 + lane]);
                        TRANSPOSE32(32 * w);
                    } else {
#pragma unroll
                        for (int k = 0; k < 32; ++k) key[32 * w + k] = 0u;
                    }
                    __builtin_amdgcn_sched_barrier(0);
                }
            }
            if (half == 0 && nvis > 4096) __syncthreads();
        } else {
#pragma unroll
            for (int k = 0; k < 64; ++k) key[64 * half + k] = 0u;
        }
    }
#undef SC_LOAD
#undef SC_TILE
    if (nvis <= 256) { for (int p = lane; p < 256; p += 64) sel[p] = p < nvis ? sel_entry(p, qpos) : 0u; }
    else {
        unsigned A[4], GT[4];
        { const int nsl = (nvis - lane + 63) >> 6;
#pragma unroll
          for (int w = 0; w < 4; ++w) { const int r = nsl - 32 * w; A[w] = r >= 32 ? 0xffffffffu : (r > 0 ? ((1u << r) - 1u) : 0u); GT[w] = 0u; } }
        int cabove = 0; bool done = false;
#pragma unroll
        for (int bit = 31; bit >= 0; --bit) {
            if (!done) {
                unsigned ones[4]; int c = 0;
#pragma unroll
                for (int w = 0; w < 4; ++w) { ones[w] = A[w] & key[32 * w + bit]; c += __builtin_popcount(ones[w]); }
                const int tot = cabove + wave_sum_i(c);
                if (tot >= 256) {
#pragma unroll
                    for (int w = 0; w < 4; ++w) A[w] = ones[w];
                    if (tot == 256) {
#pragma unroll
                        for (int w = 0; w < 4; ++w) { GT[w] |= ones[w]; A[w] = 0u; }
                        cabove = 256; done = true; }
                } else {
#pragma unroll
                    for (int w = 0; w < 4; ++w) { GT[w] |= ones[w]; A[w] &= ~key[32 * w + bit]; }
                    cabove = tot; }
            }
        }
        const int cgt = cabove, need_eq = 256 - cgt;
        { int cl = 0;
#pragma unroll
          for (int w = 0; w < 4; ++w) cl += __builtin_popcount(GT[w]);
          int x = cl;
#pragma unroll
          for (int d = 1; d < 64; d <<= 1) { const int v = __shfl_up(x, d); if (lane >= d) x += v; }
          int pos = x - cl;
#pragma unroll
          for (int w = 0; w < 4; ++w) { unsigned mk = GT[w];
              while (mk) { const int i = __builtin_ctz(mk); mk &= mk - 1u; sel[pos++] = (unsigned)((32 * w + i) * 64 + lane); } } }
        if (need_eq > 0) { int base_eq = 0;
#pragma unroll
            for (int w = 0; w < 4; ++w) { unsigned U = wave_or_u(A[w]);
                while (U != 0u && base_eq < need_eq) { const int i = __builtin_ctz(U); U &= U - 1u;
                    const bool eq = (A[w] >> i) & 1u; const unsigned long long be = __ballot(eq);
                    const int re = base_eq + (int)__builtin_amdgcn_mbcnt_hi((unsigned)(be >> 32), __builtin_amdgcn_mbcnt_lo((unsigned)be, 0u));
                    if (eq && re < need_eq) sel[cgt + re] = (unsigned)((32 * w + i) * 64 + lane);
                    base_eq += __popcll(be); } } }
        lds_wait();
        { u32x4 e4 = *(LAS u32x4*)(sel + 4 * lane);
#pragma unroll
          for (int r = 0; r < 4; ++r) e4[r] = sel_entry((int)e4[r], qpos);
          *(LAS u32x4*)(sel + 4 * lane) = e4; }
    }
    { lds_wait(); unsigned* sg_ = (unsigned*)(a->ws + WS_SEL) + (size_t)(m0 + wave) * 256; *(u32x4*)(sg_ + 4 * lane) = *(const LAS u32x4*)(sel + 4 * lane); }
    __syncthreads();
}
#undef TRANSPOSE32

constexpr int ATT_WAVE_LDS = 1024 + 32 * 160;
__device__ __forceinline__ void att_unit(ArgsP a, LAS unsigned char* lds, int qblk, int kvh) {
    int tid_ = threadIdx.x; asm volatile("" : "+v"(tid_)); const int tid = tid_, lane = tid & 63, wave = __builtin_amdgcn_readfirstlane(tid >> 6);
    const int m = qblk * 8 + wave;
    const bf16_t *Kb, *Vb;
    if (m < MP) { const int b = m >> 13; Kb = (const bf16_t*)(a->ws + WS_KP) + (size_t)b * SEQ * 256; Vb = (const bf16_t*)(a->ws + WS_VP) + (size_t)b * SEQ * 256; }
    else { const int b = (m - MP) >> 4; Kb = (const bf16_t*)(a->ws + WS_KS) + (size_t)b * LTOT * 256; Vb = (const bf16_t*)(a->ws + WS_VS) + (size_t)b * LTOT * 256; }
    Kb += kvh * 64; Vb += kvh * 64;
    bf16_t* qb = (bf16_t*)(a->ws + WS_Q);
    LAS unsigned* sel = (LAS unsigned*)(lds + wave * ATT_WAVE_LDS);
    LAS unsigned char* vst = lds + wave * ATT_WAVE_LDS + 1024;
    const LAS float* REL = (const LAS float*)(lds + LDS_AUX + 4096);
    const int j = lane & 15, kq = lane >> 4;
    { const u32x4 e = *(const u32x4*)((const unsigned*)(a->ws + WS_SEL) + (size_t)m * 256 + 4 * lane); *(LAS u32x4*)(sel + 4 * lane) = e; }
    bf16x8 qf[2];
#pragma unroll
    for (int ks = 0; ks < 2; ++ks) { u32x4 w = (u32x4){0u, 0u, 0u, 0u};
        if (j < 4) w = *(const u32x4*)(qb + (size_t)m * 1024 + (kvh * 4 + j) * 64 + 32 * ks + 8 * kq);
        qf[ks] = __builtin_bit_cast(bf16x8, w); }
    lds_wait(); __builtin_amdgcn_wave_barrier();
    f32x4 S[16];
    {
        u32x4 kr[4][4];
#pragma unroll
        for (int s = 0; s < 3; ++s)
#pragma unroll
            for (int c = 0; c < 4; ++c) { const unsigned e = sel[32 * s + 8 * c + (lane >> 3)]; kr[s][c] = *(const u32x4*)((const char*)Kb + ((e & 0xffffu) * 512u + 16u * (unsigned)(lane & 7))); }
        __builtin_amdgcn_sched_barrier(0);
#pragma unroll
        for (int s = 0; s < 8; ++s) {
            if (s + 3 < 8) {
#pragma unroll
                for (int c = 0; c < 4; ++c) { const unsigned e = sel[32 * (s + 3) + 8 * c + (lane >> 3)]; kr[(s + 3) & 3][c] = *(const u32x4*)((const char*)Kb + ((e & 0xffffu) * 512u + 16u * (unsigned)(lane & 7))); }
            }
            __builtin_amdgcn_sched_barrier(0);
#pragma unroll
            for (int c = 0; c < 4; ++c) *(LAS u32x4*)(vst + (8 * c + (lane >> 3)) * 160 + (lane & 7) * 16) = kr[s & 3][c];
            asm volatile("" ::: "memory"); __builtin_amdgcn_wave_barrier();
#pragma unroll
            for (int tt = 0; tt < 2; ++tt) { const LAS unsigned char* p = vst + (16 * tt + j) * 160 + 16 * kq;
                const bf16x8 k0 = *(const LAS bf16x8*)p, k1 = *(const LAS bf16x8*)(p + 64);
                f32x4 sacc = (f32x4){0.f, 0.f, 0.f, 0.f};
                sacc = __builtin_amdgcn_mfma_f32_16x16x32_bf16(k0, qf[0], sacc, 0, 0, 0);
                sacc = __builtin_amdgcn_mfma_f32_16x16x32_bf16(k1, qf[1], sacc, 0, 0, 0);
                S[2 * s + tt] = sacc; }
            asm volatile("" ::: "memory"); __builtin_amdgcn_wave_barrier();
        }
    }
    u32x4 vr[4][4];
#pragma unroll
    for (int s = 0; s < 3; ++s)
#pragma unroll
        for (int c = 0; c < 4; ++c) { const unsigned e = sel[32 * s + 8 * c + (lane >> 3)]; vr[s][c] = *(const u32x4*)((const char*)Vb + ((e & 0xffffu) * 512u + 16u * (unsigned)(lane & 7))); }
    __builtin_amdgcn_sched_barrier(0);
    float L[16]; float mx = -3.0e38f;
#pragma unroll
    for (int t = 0; t < 16; ++t) {
        int pk = __float_as_int(S[t][0]);
        pk = __builtin_amdgcn_update_dpp(pk, __float_as_int(S[t][1]), 0x114, 0xf, 0x2, false);
        pk = __builtin_amdgcn_update_dpp(pk, __float_as_int(S[t][2]), 0x118, 0xf, 0x4, false);
        pk = __builtin_amdgcn_update_dpp(pk, __float_as_int(S[t][3]), 0x11c, 0xf, 0x8, false);
        const unsigned e = sel[16 * t + 4 * kq + (j >> 2)];
        const float bias = REL[((e >> 16) & 31u) * 16 + kvh * 4 + (j & 3)];
        const float l = (e >> 24) ? __int_as_float(pk) * 0.125f + bias : -1e30f; L[t] = l; mx = fmaxf(mx, l); }
    mx = fmaxf(mx, __shfl_xor(mx, 4)); mx = fmaxf(mx, __shfl_xor(mx, 8)); mx = fmaxf(mx, __shfl_xor(mx, 16)); mx = fmaxf(mx, __shfl_xor(mx, 32));
    float sum = 0.f;
#pragma unroll
    for (int t = 0; t < 16; ++t) { const float p = __expf(L[t] - mx); L[t] = p; sum += p; }
    sum += __shfl_xor(sum, 4); sum += __shfl_xor(sum, 8); sum += __shfl_xor(sum, 16); sum += __shfl_xor(sum, 32);
    bf16x8 pf[8];
#pragma unroll
    for (int s = 0; s < 8; ++s) { float P[2][4];
#pragma unroll
        for (int tt = 0; tt < 2; ++tt) { const int v = __float_as_int(L[2 * s + tt]);
            P[tt][0] = __int_as_float(j < 4 ? v : 0);
            P[tt][1] = __int_as_float(__builtin_amdgcn_update_dpp(0, v, 0x104, 0xf, 0x1, true));
            P[tt][2] = __int_as_float(__builtin_amdgcn_update_dpp(0, v, 0x108, 0xf, 0x1, true));
            P[tt][3] = __int_as_float(__builtin_amdgcn_update_dpp(0, v, 0x10c, 0xf, 0x1, true)); }
        u32x4 w; w.x = pkbf(P[0][0], P[0][1]); w.y = pkbf(P[0][2], P[0][3]); w.z = pkbf(P[1][0], P[1][1]); w.w = pkbf(P[1][2], P[1][3]);
        pf[s] = __builtin_bit_cast(bf16x8, w); }
    f32x4 O[4];
#pragma unroll
    for (int dt = 0; dt < 4; ++dt) O[dt] = (f32x4){0.f, 0.f, 0.f, 0.f};
#pragma unroll
    for (int s = 0; s < 8; ++s) {
        if (s + 3 < 8) {
#pragma unroll
            for (int c = 0; c < 4; ++c) { const unsigned e = sel[32 * (s + 3) + 8 * c + (lane >> 3)]; vr[(s + 3) & 3][c] = *(const u32x4*)((const char*)Vb + ((e & 0xffffu) * 512u + 16u * (unsigned)(lane & 7))); }
        }
        __builtin_amdgcn_sched_barrier(0);
#pragma unroll
        for (int c = 0; c < 4; ++c) *(LAS u32x4*)(vst + (8 * c + (lane >> 3)) * 160 + (lane & 7) * 16) = vr[s & 3][c];
        asm volatile("" ::: "memory"); __builtin_amdgcn_wave_barrier();
#pragma unroll
        for (int dt = 0; dt < 4; ++dt) { const LAS unsigned char* p = vst + (4 * kq + (j >> 2)) * 160 + (16 * dt + 4 * (j & 3)) * 2;
            const s16x4 lo = tr_read(p), hi = tr_read(p + 16 * 160);
            const bf16x8 vf = (bf16x8){lo[0], lo[1], lo[2], lo[3], hi[0], hi[1], hi[2], hi[3]};
            O[dt] = __builtin_amdgcn_mfma_f32_16x16x32_bf16(pf[s], vf, O[dt], 0, 0, 0); }
        asm volatile("" ::: "memory"); __builtin_amdgcn_wave_barrier();
    }
    float inv[4];
#pragma unroll
    for (int r = 0; r < 4; ++r) inv[r] = 1.0f / __shfl(sum, r);
    if (kq == 0) {
#pragma unroll
        for (int r = 0; r < 4; ++r) { bf16_t* op = qb + (size_t)m * 1024 + (kvh * 4 + r) * 64 + j;
#pragma unroll
            for (int dt = 0; dt < 4; ++dt) op[16 * dt] = (bf16_t)(pkbf(O[dt][r] * inv[r], 0.f) & 0xffffu); }
    }
}

#define XB_TMO      128
#define XB_XCNT(j)  (256  + 64 * (j))
#define XB_XSUB(j)  (1280 + 64 * (j))
#define XB_XGEN(j)  (2304 + 64 * (j))
#define XB_TOP      3328
#define XB_TOPGEN   3392
#define XCD_BAR_WORDS 3456
#define XB_SPIN_CAP (1u << 18)

__device__ __forceinline__ unsigned xb_ld(unsigned* p)              { return __hip_atomic_load(p, __ATOMIC_RELAXED, __HIP_MEMORY_SCOPE_AGENT); }
__device__ __forceinline__ unsigned xb_add(unsigned* p, unsigned v) { return __hip_atomic_fetch_add(p, v, __ATOMIC_RELAXED, __HIP_MEMORY_SCOPE_AGENT); }
__device__ __forceinline__ unsigned xb_xcc_id() { return (unsigned)__builtin_amdgcn_s_getreg((3 << 11) | 20) & 0xFu; }
#define XB_SPIN(cond, bar) do { unsigned _sp = 0; while (cond) { __builtin_amdgcn_s_sleep(1); \
    if ((++_sp & 255u) == 0u) { if (xb_ld(&(bar)[XB_TMO])) break; if (_sp > XB_SPIN_CAP) { atomicAdd(&(bar)[XB_TMO], 1u); break; } } } } while (0)

struct XcdBarrier {
    unsigned* bar; unsigned x;
    volatile LAS unsigned* st;
};

__device__ __forceinline__ XcdBarrier xcd_barrier_post(unsigned* bar, volatile LAS unsigned* st) {
    XcdBarrier b; b.bar = bar; b.x = xb_xcc_id(); b.st = st;
    if (threadIdx.x == 0) (void)xb_add(&bar[XB_XCNT(b.x)], 1u);
    return b;
}
__device__ __forceinline__ void xcd_barrier_complete(unsigned* bar, unsigned x, unsigned& nloc, unsigned& nx) {
    const unsigned G = gridDim.x * gridDim.y * gridDim.z;
    unsigned sum, cnt, mine, sp = 0u;
    for (;;) {
        sum = 0u; cnt = 0u; mine = 0u;
#pragma unroll
        for (unsigned j = 0; j < 16; ++j) { const unsigned c = xb_ld(&bar[XB_XCNT(j)]); sum += c; cnt += (c > 0u) ? 1u : 0u; mine = (j == x) ? c : mine; }
        if (sum == G) break;
        __builtin_amdgcn_s_sleep(1);
        if ((++sp & 255u) == 0u) { if (xb_ld(&bar[XB_TMO])) break; if (sp > XB_SPIN_CAP) { atomicAdd(&bar[XB_TMO], 1u); break; } }
    }
    nloc = mine > 0u ? mine : 1u; nx = cnt > 0u ? cnt : 1u;
}

__device__ __forceinline__ void xcd_barrier(const XcdBarrier& b) {
    asm volatile("s_waitcnt vmcnt(0)" ::: "memory");
    __syncthreads();
    if (threadIdx.x == 0) {
        unsigned* bar = b.bar;
        __builtin_amdgcn_s_waitcnt(0);
        unsigned nloc = b.st[0], nx = b.st[1];
        if (nloc == 0u) { xcd_barrier_complete(bar, b.x, nloc, nx); b.st[0] = nloc; b.st[1] = nx; }
        const unsigned old = xb_add(&bar[XB_XSUB(b.x)], 1u);
        const unsigned gen = old / nloc;
        if (old + 1u == (gen + 1u) * nloc) {
            __builtin_amdgcn_fence(__ATOMIC_RELEASE, "agent");
            asm volatile("s_waitcnt vmcnt(0)" ::: "memory");
            const unsigned og = xb_add(&bar[XB_TOP], 1u);
            const unsigned tg = og / nx;
            if (og + 1u == (tg + 1u) * nx) xb_add(&bar[XB_TOPGEN], 1u);
            else XB_SPIN(xb_ld(&bar[XB_TOPGEN]) == tg, bar);
            __builtin_amdgcn_fence(__ATOMIC_ACQUIRE, "agent");
            xb_add(&bar[XB_XGEN(b.x)], 1u);
            asm volatile("s_waitcnt vmcnt(0)" ::: "memory");
        } else {
            XB_SPIN(xb_ld(&bar[XB_XGEN(b.x)]) == gen, bar);
            __builtin_amdgcn_fence(__ATOMIC_ACQUIRE, "agent");
            asm volatile("s_waitcnt vmcnt(0)" ::: "memory");
        }
    }
    __syncthreads();
}

__global__ void __launch_bounds__(NTHREADS, 2) fwd_megakernel(Args args_unused) {
    extern __shared__ __attribute__((aligned(16))) unsigned char lds_raw[];
    LAS unsigned char* lds = (LAS unsigned char*)lds_raw;
    cg::grid_group grid = cg::this_grid();
    const int G = gridDim.x, tid = threadIdx.x;
    ArgsP ap = (ArgsP)__builtin_amdgcn_kernarg_segment_ptr();
    unsigned char* ws; float* out;
#define FRESH() do { asm volatile("" : "+s"(ap)); ws = ap->ws; out = ap->out; } while (0)
#define args (*ap)
#define ARGP ap
    FRESH();
    volatile LAS unsigned* bst = (volatile LAS unsigned*)(lds + LDS_BYTES - 64);
    if (tid < 2) bst[tid] = 0u;
    if (blockIdx.x == 0) for (int i = tid; i < XCD_BAR_WORDS; i += NTHREADS) ((unsigned*)(ws + WS_BAR))[i] = 0u;
#ifndef PHM
#define PHM 0xffff
#endif
#define HAS(k) ((PHM >> (k)) & 1)
#define GEMM_UP(Aptr, Woff) do { if (HAS(1)) { pg8::Gemm g{Aptr, (const bf16_t*)(ws + (Woff)), MT, NUP, 1024}; pg8::StaticOrder S; S.init(MT, NUP, G, (int)blockIdx.x); \
        pg8::EpiUp E{(bf16_t*)(ws + WS_HID)}; pg8::gemm_phase<pg8::EpiUp, pg8::StaticOrder, true, true>(lds, g, S, E); } } while (0)
#define GEMM_DOWN(Aptr, Woff, KK, RESB, SCALE, PREOFF) do { if (HAS(2)) { pg8::Gemm g{Aptr, (const bf16_t*)(ws + (Woff)), MT, 1024, KK}; pg8::StaticOrder S; S.init(MT, 1024, G, (int)blockIdx.x); \
        pg8::EpiDown E{(bf16_t*)(ws + (PREOFF)), args.in[0], args.in[1], RESB, SCALE}; pg8::gemm_phase<pg8::EpiDown, pg8::StaticOrder, true, true>(lds, g, S, E); } } while (0)
#define GEMM_BR(Aptr, Woff, GATE, MODE) do { if (HAS(7)) { pg8::Gemm g{Aptr, (const bf16_t*)(ws + (Woff)), MT, 1024, 1024}; pg8::StaticOrder S; S.init(MT, 1024, G, (int)blockIdx.x); \
        pg8::EpiBr E{(bf16_t*)(ws + WS_VPRE), GATE, MODE}; pg8::gemm_phase<pg8::EpiBr, pg8::StaticOrder, true, true>(lds, g, S, E); } } while (0)
    if (HAS(0)) prologue(ap, lds, G);
    grid.sync(); FRESH();
    XcdBarrier xbar = xcd_barrier_post((unsigned*)(ws + WS_BAR), bst);
#define GSYNC() do { xbar.bar = (unsigned*)(ws + WS_BAR); xcd_barrier(xbar); FRESH(); } while (0)
    GEMM_UP((const bf16_t*)(ws + WS_XB), WS_W1U);
    GSYNC();
    GEMM_DOWN((const bf16_t*)(ws + WS_HID), WS_W1D, FF, (const bf16_t*)nullptr, 0.5f, WS_PRE1);
    GSYNC();
    if (HAS(3)) ln_phase((const bf16_t*)(ws + WS_PRE1), args.in[6], args.in[7], (bf16_t*)(ws + WS_H1), nullptr, G);
    GSYNC();
    if (HAS(4)) { pg8::Gemm g{(const bf16_t*)(ws + WS_H1), (const bf16_t*)(ws + WS_WIN), MT, NWIN, 1024}; pg8::StaticOrder S; S.init(MT, NWIN, G, (int)blockIdx.x);
        pg8::EpiWin E{ws, out}; pg8::gemm_phase<pg8::EpiWin, pg8::StaticOrder, true, true>(lds, g, S, E); }
    GSYNC();
    if (HAS(5)) for (int u = blockIdx.x; u < 544; u += G) gate_unit(ap, lds, u);
    if (HAS(6)) {
        if (G == 256) {
            const int k = blockIdx.x;
            if (k < 64) sel_unit(ap, lds, k);
            for (int i = 0; i < 32; ++i) { const int r = i & 3, p = (r & 1) ? (256 * (r + 1) - 1 - k) : (256 * r + k); sel_unit(ap, lds, 64 + (i >> 2) * 1024 + p); }
        } else for (int u = blockIdx.x; u < 64 + 8192; u += G) sel_unit(ap, lds, u);
    }
    GSYNC();
    if (HAS(6)) { { LAS float* REL = (LAS float*)(lds + LDS_AUX + 4096); if (tid < 512) REL[tid] = args.in[5][tid]; }
        __syncthreads();
        if ((G & 7) == 0) { const int bid = blockIdx.x, kvh = bid & 3, par = (bid >> 2) & 1, rank = bid >> 3, nrank = G >> 3;
            for (int qb = 2 * rank + par; qb < MT / 8; qb += 2 * nrank) att_unit(ap, lds, qb, kvh); }
        else for (int u = blockIdx.x; u < (MT / 8) * 4; u += G) att_unit(ap, lds, u >> 2, u & 3); }
    GSYNC();
    GEMM_BR((const bf16_t*)(ws + WS_Q), WS_WA, (const bf16_t*)out, 0);
    FRESH();
    GEMM_BR((const bf16_t*)(ws + WS_U), WS_WB, (const bf16_t*)out + (size_t)MT * 1024, 1);
    GSYNC();
    GEMM_DOWN((const bf16_t*)(ws + WS_VPRE), WS_WO, 1024, (const bf16_t*)(ws + WS_H1), 1.0f, WS_PRE2);
    GSYNC();
    if (HAS(3)) ln_phase((const bf16_t*)(ws + WS_PRE2), args.in[19], args.in[20], (bf16_t*)(ws + WS_XB), nullptr, G);
    GSYNC();
    GEMM_UP((const bf16_t*)(ws + WS_XB), WS_W2U);
    GSYNC();
    GEMM_DOWN((const bf16_t*)(ws + WS_HID), WS_W2D, FF, (const bf16_t*)(ws + WS_XB), 0.5f, WS_PRE3);
    GSYNC();
    if (HAS(3)) ln_phase((const bf16_t*)(ws + WS_PRE3), args.in[24], args.in[25], nullptr, out, G);
#undef args
}

extern "C" void kernel_launch(void* const* d_in, const int* in_sizes, int n_in, void* d_out, int out_size, void* d_ws, size_t ws_size, hipStream_t stream) {
    static int grid = 0;
    if (grid == 0) {
        if (n_in != 26 || ws_size < WS_END || (size_t)out_size != O_END || ws_size < 1024 * MiB) { fprintf(stderr, "kernel_launch: unexpected shapes n_in %d out %d ws %zu\n", n_in, out_size, ws_size); grid = -1; return; }
        int dev = 0, cus = 0, per_cu = 0;
        hipGetDevice(&dev); hipDeviceGetAttribute(&cus, hipDeviceAttributeMultiprocessorCount, dev);
        if (hipFuncSetAttribute((const void*)fwd_megakernel, hipFuncAttributeMaxDynamicSharedMemorySize, LDS_BYTES) != hipSuccess) { fprintf(stderr, "kernel_launch: hipFuncSetAttribute failed\n"); grid = -1; return; }
        if (hipOccupancyMaxActiveBlocksPerMultiprocessor(&per_cu, (const void*)fwd_megakernel, NTHREADS, LDS_BYTES) != hipSuccess || per_cu < 1) { fprintf(stderr, "kernel_launch: occupancy query says %d\n", per_cu); per_cu = 1; }
        (void)hipGetLastError();
        grid = cus * per_cu;
    }
    if (grid < 0) return;
    Args a{};
    for (int i = 0; i < 26; ++i) a.in[i] = (const float*)d_in[i];
    a.out = (float*)d_out; a.ws = (unsigned char*)d_ws;
    void* kargs[] = {&a};
    hipError_t e = hipLaunchCooperativeKernel((const void*)fwd_megakernel, dim3(grid), dim3(NTHREADS), kargs, LDS_BYTES, stream);
    if (e != hipSuccess) fprintf(stderr, "cooperative launch failed: %s (grid %d)\n", hipGetErrorString(e), grid);
}
```

```cpp
#include <hip/hip_runtime.h>
#include <hip/hip_cooperative_groups.h>
#include <cstdio>
#include <cstdint>
namespace cg = cooperative_groups;

constexpr int MP = 65536, MS = 512, MT = MP + MS, DM = 1024, FF = 2816, NUP = 2 * FF, NWIN = 6400, WIN_SRC = 6216;
constexpr int SEQ = 8192, LTOT = 1040;
constexpr float LN_EPS = 1e-5f;
constexpr int NWAVES = 8, NTHREADS = 512;
constexpr int LDS_BYTES = 163840;
constexpr size_t O_YP = 0, O_YS = (size_t)MP * 1024, O_KP = O_YS + (size_t)MS * 1024, O_VP = O_KP + (size_t)MP * 256, O_KIP = O_VP + (size_t)MP * 256,
                 O_KS = O_KIP + (size_t)MP * 64, O_VS = O_KS + (size_t)MS * 256, O_KIS = O_VS + (size_t)MS * 256, O_GV = O_KIS + (size_t)MS * 64, O_END = O_GV + (size_t)MS * 1024;
constexpr size_t MiB = 1u << 20;
constexpr size_t WS_BAR = 64 * 1024;
constexpr size_t WS_W1U = 1 * MiB, WS_W1D = 12 * MiB, WS_W2U = 18 * MiB, WS_W2D = 29 * MiB, WS_WIN = 35 * MiB, WS_WA = 48 * MiB, WS_WB = 50 * MiB, WS_WO = 52 * MiB, WS_WGM = 54 * MiB;
constexpr size_t WS_KS = 55 * MiB, WS_VS = 72 * MiB, WS_KIS = 89 * MiB;
constexpr size_t WS_XB = 104 * MiB, WS_H1 = 233 * MiB, WS_HID = 362 * MiB;
constexpr size_t WS_Q = 362 * MiB, WS_U = 491 * MiB, WS_VPRE = 620 * MiB, WS_QI = 749 * MiB, WS_KP = 814 * MiB, WS_VP = 846 * MiB, WS_KIP = 878 * MiB, WS_WI = 886 * MiB, WS_SEL = 890 * MiB, WS_END = 956 * MiB;
constexpr size_t WS_PRE1 = WS_SEL, WS_PRE2 = WS_Q, WS_PRE3 = WS_H1;
static_assert(WS_SEL + (size_t)MT * 1024 * 2 <= 1024 * MiB, "pre1 fits the workspace");
static_assert((size_t)MT * 1024 * 2 <= 129 * MiB && (size_t)MT * FF * 2 <= 355 * MiB && (size_t)MT * 512 * 2 <= 65 * MiB, "ws map");


namespace pg8 {
#define PG8_LAS __attribute__((address_space(3)))
typedef unsigned short bf16_t;
typedef short bf16x8 __attribute__((ext_vector_type(8)));
typedef float f32x4 __attribute__((ext_vector_type(4)));
typedef unsigned u32x4 __attribute__((ext_vector_type(4)));
constexpr int BM = 256, BK = 64, HALF = 128, HTB = HALF * BK * 2  , STAGE_BYTES = 8 * HTB, NXCD = 8, WGM = 8;

__host__ __device__ __forceinline__ int lds_byte(int r, int c) { const int st = (r >> 4) * 2 + (c >> 5), rr = r & 15, cc = c & 31, ob = rr * 64 + cc * 2; return st * 1024 + (ob ^ (((ob >> 9) & 1) << 5)); }
__host__ __device__ __forceinline__ void stage_rc(int b, int& R, int& C) { const int st = b / 1024, sb = b % 1024, swz = sb ^ (((sb >> 9) & 1) << 5); R = (st >> 1) * 16 + swz / 64; C = (st & 1) * 32 + (swz % 64) / 2; }
__host__ __device__ __forceinline__ int perm32(int rho) { const int n = rho >> 4, i = rho & 15; return 8 * (i >> 2) + 4 * n + (i & 3); }

struct Unit { int pm, pn; };
struct Gemm { const bf16_t* A; const bf16_t* Bt; int M, N, K; };

struct StaticOrder {
    int nM, nN, nwg, G, c;
    __host__ __device__ void init(int M, int N, int G_, int c_) { nM = M / BM; nN = N / BM; nwg = nM * nN; G = G_; c = c_; }
    __host__ __device__ bool next(int i, Unit& u) const {
        const long L = (long)i * G + c; if (L >= nwg) return false;
        int wgid = (int)L; { const int q = nwg / NXCD, r = nwg % NXCD, xcd = wgid % NXCD, off = wgid / NXCD; wgid = (xcd < r ? xcd * (q + 1) : r * (q + 1) + (xcd - r) * q) + off; }
        const int nig = WGM * nN, gid = wgid / nig, fm = gid * WGM, gsz = (nM - fm) < WGM ? (nM - fm) : WGM;
        u.pm = fm + ((wgid % nig) % gsz); u.pn = (wgid % nig) / gsz; return true;
    }
    __device__ __forceinline__ void a_ready(const Unit&) const {}
    __device__ __forceinline__ void done(const Unit&) const {}
};

typedef float f32x2v __attribute__((ext_vector_type(2)));
typedef __bf16 bf16x2v __attribute__((ext_vector_type(2)));
__device__ __forceinline__ unsigned pkbf(float lo, float hi) { f32x2v v = {lo, hi}; bf16x2v b = __builtin_convertvector(v, bf16x2v); return __builtin_bit_cast(unsigned, b); }
__device__ __forceinline__ float bflo(unsigned w) { return __uint_as_float(w << 16); }
__device__ __forceinline__ float bfhi(unsigned w) { return __uint_as_float(w & 0xffff0000u); }
__device__ __forceinline__ float fsigmoid(float x) { return __builtin_amdgcn_rcpf(1.0f + __expf(-x)); }
__device__ __forceinline__ float fgelu(float x) { const float t = 1.5957691216057308f * (x + 0.044715f * x * x * x); return x * fsigmoid(t); }
constexpr int E_MP = MP;
constexpr float E_ALPHA = 1.189207115002721f;

struct EpiUp {
    static constexpr bool PERM = true, AFTER_DRAIN = false;
    bf16_t* O;
    __device__ __forceinline__ void operator()(const f32x4 (&acc)[2][2][4][2], const Unit& u, int wr, int wc, int fr, int fq) const {
        const int row0 = u.pm * BM + wr * 64 + fr, col0 = u.pn * 128 + wc * 32 + 8 * fq;
#pragma unroll
        for (int ai = 0; ai < 2; ++ai)
#pragma unroll
            for (int m = 0; m < 4; ++m) {
                float h[8];
#pragma unroll
                for (int n = 0; n < 2; ++n)
#pragma unroll
                    for (int e = 0; e < 4; ++e) { const float g = acc[ai][0][m][n][e], up = acc[ai][1][m][n][e]; h[4 * n + e] = g * fsigmoid(g) * up; }
                u32x4 w; w.x = pkbf(h[0], h[1]); w.y = pkbf(h[2], h[3]); w.z = pkbf(h[4], h[5]); w.w = pkbf(h[6], h[7]);
                *(u32x4*)(O + (size_t)(row0 + ai * HALF + m * 16) * 2816 + col0) = w;
            }
    }
};
struct EpiDown {
    static constexpr bool PERM = true, AFTER_DRAIN = false;
    bf16_t* out; const float* xp; const float* xs; const bf16_t* resb; float scale;
    __device__ __forceinline__ void operator()(const f32x4 (&acc)[2][2][4][2], const Unit& u, int wr, int wc, int fr, int fq) const {
        const int row0 = u.pm * BM + wr * 64 + fr, col0 = u.pn * BM + wc * 32 + 8 * fq;
#pragma unroll
        for (int ai = 0; ai < 2; ++ai) {
            if (resb) {
                u32x4 rw[4][2];
#pragma unroll
                for (int m = 0; m < 4; ++m)
#pragma unroll
                    for (int bj = 0; bj < 2; ++bj) rw[m][bj] = *(const u32x4*)(resb + (size_t)(row0 + ai * HALF + m * 16) * 1024 + col0 + bj * HALF);
#pragma unroll
                for (int m = 0; m < 4; ++m)
#pragma unroll
                    for (int bj = 0; bj < 2; ++bj) { const u32x4 w0 = rw[m][bj];
                        const f32x4 r0 = (f32x4){bflo(w0.x), bfhi(w0.x), bflo(w0.y), bfhi(w0.y)}, r1 = (f32x4){bflo(w0.z), bfhi(w0.z), bflo(w0.w), bfhi(w0.w)};
                        const f32x4 o0 = r0 * E_ALPHA + acc[ai][bj][m][0] * scale, o1 = r1 * E_ALPHA + acc[ai][bj][m][1] * scale;
                        u32x4 w; w.x = pkbf(o0[0], o0[1]); w.y = pkbf(o0[2], o0[3]); w.z = pkbf(o1[0], o1[1]); w.w = pkbf(o1[2], o1[3]);
                        *(u32x4*)(out + (size_t)(row0 + ai * HALF + m * 16) * 1024 + col0 + bj * HALF) = w; }
                asm volatile("" ::: "memory");
            } else {
#pragma unroll
                for (int m = 0; m < 4; m += 2) {
                    f32x4 rf[2][2][2];
#pragma unroll
                    for (int mm = 0; mm < 2; ++mm) { const int row = row0 + ai * HALF + (m + mm) * 16;
                        const float* rp = (row < E_MP ? xp + (size_t)row * 1024 : xs + (size_t)(row - E_MP) * 1024) + col0;
#pragma unroll
                        for (int bj = 0; bj < 2; ++bj) { rf[mm][bj][0] = *(const f32x4*)(rp + bj * HALF); rf[mm][bj][1] = *(const f32x4*)(rp + bj * HALF + 4); } }
#pragma unroll
                    for (int mm = 0; mm < 2; ++mm)
#pragma unroll
                        for (int bj = 0; bj < 2; ++bj) { const f32x4 o0 = rf[mm][bj][0] * E_ALPHA + acc[ai][bj][m + mm][0] * scale, o1 = rf[mm][bj][1] * E_ALPHA + acc[ai][bj][m + mm][1] * scale;
                            u32x4 w; w.x = pkbf(o0[0], o0[1]); w.y = pkbf(o0[2], o0[3]); w.z = pkbf(o1[0], o1[1]); w.w = pkbf(o1[2], o1[3]);
                            *(u32x4*)(out + (size_t)(row0 + ai * HALF + (m + mm) * 16) * 1024 + col0 + bj * HALF) = w; }
                    asm volatile("" ::: "memory");
                }
            }
        }
    }
};
struct EpiBr {
    static constexpr bool PERM = true, AFTER_DRAIN = false;
    bf16_t* mb; const bf16_t* gate; int mode;
    __device__ __forceinline__ void operator()(const f32x4 (&acc)[2][2][4][2], const Unit& u, int wr, int wc, int fr, int fq) const {
        const int row0 = u.pm * BM + wr * 64 + fr, col0 = u.pn * BM + wc * 32 + 8 * fq;
#pragma unroll
        for (int ai = 0; ai < 2; ++ai) {
            u32x4 gw[4][2], pw[4][2];
#pragma unroll
            for (int m = 0; m < 4; ++m)
#pragma unroll
                for (int bj = 0; bj < 2; ++bj) { const size_t off = (size_t)(row0 + ai * HALF + m * 16) * 1024 + col0 + bj * HALF;
                    gw[m][bj] = *(const u32x4*)(gate + off); pw[m][bj] = (u32x4){0u, 0u, 0u, 0u}; if (mode) pw[m][bj] = *(const u32x4*)(mb + off); }
#pragma unroll
            for (int m = 0; m < 4; ++m)
#pragma unroll
                for (int bj = 0; bj < 2; ++bj) { const size_t off = (size_t)(row0 + ai * HALF + m * 16) * 1024 + col0 + bj * HALF;
                    const u32x4 g = gw[m][bj], p = pw[m][bj];
                    float v[8];
                    v[0] = bflo(g.x) * acc[ai][bj][m][0][0] + bflo(p.x); v[1] = bfhi(g.x) * acc[ai][bj][m][0][1] + bfhi(p.x); v[2] = bflo(g.y) * acc[ai][bj][m][0][2] + bflo(p.y); v[3] = bfhi(g.y) * acc[ai][bj][m][0][3] + bfhi(p.y);
                    v[4] = bflo(g.z) * acc[ai][bj][m][1][0] + bflo(p.z); v[5] = bfhi(g.z) * acc[ai][bj][m][1][1] + bfhi(p.z); v[6] = bflo(g.w) * acc[ai][bj][m][1][2] + bflo(p.w); v[7] = bfhi(g.w) * acc[ai][bj][m][1][3] + bfhi(p.w);
                    u32x4 w; w.x = pkbf(v[0], v[1]); w.y = pkbf(v[2], v[3]); w.z = pkbf(v[4], v[5]); w.w = pkbf(v[6], v[7]);
                    *(u32x4*)(mb + off) = w; }
            asm volatile("" ::: "memory");
        }
    }
};
struct EpiWin {
    static constexpr bool PERM = true, AFTER_DRAIN = false;
    unsigned char* ws; float* out;
    __device__ __forceinline__ void operator()(const f32x4 (&acc)[2][2][4][2], const Unit& u, int wr, int wc, int fr, int fq) const {
        const int row0 = u.pm * BM + wr * 64 + fr, cw = wc * 32 + 8 * fq, pn = u.pn;
        int act = 0, pitch = 1024, ctile = 0; size_t bbase = 0; bool b_in_out = false;
        if (pn < 4) { bbase = WS_Q; ctile = pn * 256; }
        else if (pn < 6) { pitch = 256; }
        else if (pn < 8) { bbase = WS_QI; pitch = 512; ctile = (pn - 6) * 256; }
        else if (pn == 8) { pitch = 64; }
        else if (pn < 13) { bbase = WS_U; ctile = (pn - 9) * 256; act = 1; }
        else if (pn < 17) { bbase = WS_VPRE; ctile = (pn - 13) * 256; act = 1; }
        else if (pn < 21) { bbase = 0; b_in_out = true; ctile = (pn - 17) * 256; act = 2; }
        else { bbase = (size_t)MT * 1024 * 2; b_in_out = true; ctile = (pn - 21) * 256; act = 2; }
#pragma unroll
        for (int ai = 0; ai < 2; ++ai)
#pragma unroll
            for (int m = 0; m < 4; ++m) {
                const int row = row0 + ai * HALF + m * 16;
                const bool samp = row >= E_MP; const int rs = row - E_MP; const int srow = (rs >> 4) * 1040 + 1024 + (rs & 15);
#pragma unroll
                for (int bj = 0; bj < 2; ++bj) {
                    const int cc = cw + bj * HALF;
                    float v[8];
#pragma unroll
                    for (int e = 0; e < 4; ++e) { v[e] = acc[ai][bj][m][0][e]; v[4 + e] = acc[ai][bj][m][1][e]; }
                    if (act == 1) {
#pragma unroll
                        for (int e = 0; e < 8; ++e) v[e] = fgelu(v[e]); }
                    else if (act == 2) {
#pragma unroll
                        for (int e = 0; e < 8; ++e) v[e] = fsigmoid(v[e]); }
                    bf16_t* dst = nullptr; float* fo = nullptr;
                    if (pn == 4 || pn == 5) {
                        const size_t bo = samp ? (pn == 4 ? WS_KS : WS_VS) + ((size_t)srow * 256 + cc) * 2 : (pn == 4 ? WS_KP : WS_VP) + ((size_t)row * 256 + cc) * 2;
                        dst = (bf16_t*)(ws + bo);
                        fo = out + (samp ? (pn == 4 ? O_KS : O_VS) + (size_t)rs * 256 + cc : (pn == 4 ? O_KP : O_VP) + (size_t)row * 256 + cc);
                    } else if (pn == 8) {
                        if (cc < 64) { dst = (bf16_t*)(ws + (samp ? WS_KIS + ((size_t)srow * 64 + cc) * 2 : WS_KIP + ((size_t)row * 64 + cc) * 2));
                                       fo = out + (samp ? O_KIS + (size_t)rs * 64 + cc : O_KIP + (size_t)row * 64 + cc); }
                        else if (cc == 64) fo = (float*)(ws + WS_WI) + (size_t)row * 8;
                    } else {
                        const size_t bo = bbase + ((size_t)row * pitch + ctile + cc) * 2;
                        dst = (bf16_t*)((b_in_out ? (unsigned char*)out : ws) + bo);
                    }
                    if (fo) { *(f32x4*)fo = (f32x4){v[0], v[1], v[2], v[3]}; *(f32x4*)(fo + 4) = (f32x4){v[4], v[5], v[6], v[7]}; }
                    if (dst) { u32x4 w; w.x = pkbf(v[0], v[1]); w.y = pkbf(v[2], v[3]); w.z = pkbf(v[4], v[5]); w.w = pkbf(v[6], v[7]); *(u32x4*)dst = w; }
                }
                asm volatile("" ::: "memory");
            }
    }
};

template <class Epi, class Sched, bool ALIGN_EPI = false, bool SP2 = false>
__device__ __forceinline__ void gemm_phase(PG8_LAS unsigned char* lds, const Gemm g, const Sched& S, const Epi& E) {
    int tid_ = threadIdx.x; asm volatile("" : "+v"(tid_)); const int tid = tid_, wid = __builtin_amdgcn_readfirstlane(tid >> 6), lane = tid & 63, wr = wid >> 2, wc = wid & 3, fr = lane & 15, fq = lane >> 4;
    const int K = g.K, nt = K / BK;
    unsigned voffA[2], voffB[2];
#pragma unroll
    for (int i = 0; i < 2; ++i) { int R, C; stage_rc(tid * 16 + i * 8192, R, C); const int Rb = Epi::PERM ? ((R & ~31) + perm32(R & 31)) : R;
        voffA[i] = (unsigned)(R * K + C) * 2u; voffB[i] = (unsigned)(Rb * K + C) * 2u; }
    const size_t kstep = (size_t)(BK * 2);
    const size_t hstep = (size_t)HALF * K * 2;
    const size_t tstep = 2 * hstep;
    const unsigned ldsw = (unsigned)wid * 1024u;
    const int aoff = lds_byte(wr * 64 + fr, fq * 8), boff = lds_byte(wc * 32 + fr, fq * 8);
#define PG8_SA(b, h) (((b) * 2 + (h)) * HTB)
#define PG8_SB(b, h) ((4 + (b) * 2 + (h)) * HTB)
#define PG8_STAGE(bufoff, gbase, voff) do { _Pragma("unroll") for (int _i = 0; _i < 2; ++_i) \
        __builtin_amdgcn_global_load_lds((const unsigned*)((const char*)(gbase) + (voff)[_i]), (PG8_LAS unsigned*)(lds + (bufoff) + ldsw + _i * 8192), 16, 0, 0); } while (0)
#define PG8_LDA(dst, b, h) do { _Pragma("unroll") for (int m = 0; m < 4; ++m) _Pragma("unroll") for (int k = 0; k < 2; ++k) dst[m][k] = *(const PG8_LAS bf16x8*)(lds + PG8_SA(b, h) + aoff + m * 2048 + k * 1024); } while (0)
#define PG8_LDB(dst, b, h) do { _Pragma("unroll") for (int n = 0; n < 2; ++n) _Pragma("unroll") for (int k = 0; k < 2; ++k) dst[n][k] = *(const PG8_LAS bf16x8*)(lds + PG8_SB(b, h) + boff + n * 2048 + k * 1024); } while (0)
#define PG8_MMA(ai, bj, At, Bt) do { __builtin_amdgcn_s_setprio(1); _Pragma("unroll") for (int m = 0; m < 4; ++m) _Pragma("unroll") for (int n = 0; n < 2; ++n) _Pragma("unroll") for (int k = 0; k < 2; ++k) \
        acc[ai][bj][m][n] = __builtin_amdgcn_mfma_f32_16x16x32_bf16(Bt[n][k], At[m][k], acc[ai][bj][m][n], 0, 0, 0); __builtin_amdgcn_s_setprio(0); } while (0)
#define PG8_WAIT_V(n) asm volatile("s_waitcnt vmcnt(" #n ")" ::: "memory")
#define PG8_WAIT_L(n) asm volatile("s_waitcnt lgkmcnt(" #n ")" ::: "memory")
#define PG8_BAR __builtin_amdgcn_s_barrier()
#define PG8_SCHED __builtin_amdgcn_sched_barrier(0)
    Unit cur, nxt; int ui = 0;
    if (!S.next(0, cur)) return;
    f32x4 acc[2][2][4][2];
#pragma unroll
    for (int a = 0; a < 2; ++a)
#pragma unroll
        for (int b = 0; b < 2; ++b)
#pragma unroll
            for (int m = 0; m < 4; ++m)
#pragma unroll
                for (int n = 0; n < 2; ++n) acc[a][b][m][n] = (f32x4){0.f, 0.f, 0.f, 0.f};
    bf16x8 At[4][2], B0[2][2], B1[2][2];
    const char* cA = (const char*)g.A + (size_t)cur.pm * tstep; const char* cB = (const char*)g.Bt + (size_t)cur.pn * tstep;
    S.a_ready(cur);
    if constexpr (SP2) {
        PG8_STAGE(PG8_SB(0, 0), cB, voffB); PG8_STAGE(PG8_SB(0, 1), cB + hstep, voffB); PG8_STAGE(PG8_SA(0, 0), cA, voffA); PG8_STAGE(PG8_SA(0, 1), cA + hstep, voffA);
        if (wr == 1) PG8_BAR;
        PG8_WAIT_V(2); PG8_BAR;
        PG8_STAGE(PG8_SB(1, 0), cB + kstep, voffB); PG8_STAGE(PG8_SA(1, 0), cA + kstep, voffA); PG8_STAGE(PG8_SB(1, 1), cB + hstep + kstep, voffB);
        PG8_WAIT_V(6); PG8_BAR;
    } else {
        PG8_STAGE(PG8_SB(0, 0), cB, voffB); PG8_STAGE(PG8_SA(0, 0), cA, voffA); PG8_STAGE(PG8_SB(0, 1), cB + hstep, voffB); PG8_STAGE(PG8_SA(0, 1), cA + hstep, voffA);
        if (wr == 1) PG8_BAR;
        PG8_WAIT_V(4); PG8_BAR;
        PG8_STAGE(PG8_SB(1, 0), cB + kstep, voffB); PG8_STAGE(PG8_SA(1, 0), cA + kstep, voffA); PG8_STAGE(PG8_SB(1, 1), cB + hstep + kstep, voffB);
        PG8_WAIT_V(6); PG8_BAR;
    }
    for (;;) {
        const bool has_next = S.next(ui + 1, nxt);
        const char* nA = has_next ? (const char*)g.A + (size_t)nxt.pm * tstep : cA; const char* nB = has_next ? (const char*)g.Bt + (size_t)nxt.pn * tstep : cB;
        for (int t = 0; t < nt; t += 2) {
            const bool last = (t == nt - 2);
            const char* a1 = cA + (size_t)(t + 1) * kstep;
            const char* a2 = last ? nA : cA + (size_t)(t + 2) * kstep; const char* b2 = last ? nB : cB + (size_t)(t + 2) * kstep;
            const char* a3 = a2 + kstep; const char* b3 = b2 + kstep;
            if (last && has_next) S.a_ready(nxt);
            if constexpr (SP2) {
            PG8_LDB(B0, 0, 0); PG8_LDB(B1, 0, 1); PG8_SCHED; PG8_LDA(At, 0, 0); PG8_STAGE(PG8_SA(1, 1), a1 + hstep, voffA);
            PG8_WAIT_V(8); PG8_WAIT_L(0); PG8_BAR; PG8_MMA(0, 0, At, B0); PG8_MMA(0, 1, At, B1); PG8_BAR; PG8_SCHED;
            PG8_LDA(At, 0, 1); PG8_STAGE(PG8_SB(0, 0), b2, voffB); PG8_STAGE(PG8_SB(0, 1), b2 + hstep, voffB); PG8_STAGE(PG8_SA(0, 0), a2, voffA);
            PG8_WAIT_V(8); PG8_WAIT_L(0); PG8_BAR; PG8_MMA(1, 0, At, B0); PG8_MMA(1, 1, At, B1); PG8_BAR; PG8_SCHED;
            PG8_LDB(B0, 1, 0); PG8_LDB(B1, 1, 1); PG8_SCHED; PG8_LDA(At, 1, 0); PG8_STAGE(PG8_SA(0, 1), a2 + hstep, voffA);
            PG8_WAIT_V(8); PG8_WAIT_L(0); PG8_BAR; PG8_MMA(0, 0, At, B0); PG8_MMA(0, 1, At, B1); PG8_BAR; PG8_SCHED;
            PG8_LDA(At, 1, 1); PG8_STAGE(PG8_SB(1, 0), b3, voffB); PG8_STAGE(PG8_SB(1, 1), b3 + hstep, voffB); PG8_STAGE(PG8_SA(1, 0), a3, voffA);
            PG8_WAIT_V(8); PG8_WAIT_L(0); PG8_BAR; PG8_MMA(1, 0, At, B0); PG8_MMA(1, 1, At, B1); PG8_BAR; PG8_SCHED;
            } else {
            PG8_LDB(B0, 0, 0); PG8_SCHED; PG8_LDA(At, 0, 0); PG8_STAGE(PG8_SA(1, 1), a1 + hstep, voffA);
            PG8_WAIT_L(8); PG8_BAR; PG8_WAIT_L(0); PG8_MMA(0, 0, At, B0); PG8_BAR; PG8_SCHED;
            PG8_LDB(B1, 0, 1); PG8_STAGE(PG8_SB(0, 0), b2, voffB);
            PG8_BAR; PG8_WAIT_L(0); PG8_MMA(0, 1, At, B1); PG8_BAR;
            PG8_LDA(At, 0, 1); PG8_STAGE(PG8_SA(0, 0), a2, voffA);
            PG8_BAR; PG8_WAIT_L(0); PG8_MMA(1, 0, At, B0); PG8_BAR; PG8_SCHED;
            PG8_STAGE(PG8_SB(0, 1), b2 + hstep, voffB);
            PG8_WAIT_V(6); PG8_BAR; PG8_MMA(1, 1, At, B1); PG8_BAR;
            PG8_LDB(B0, 1, 0); PG8_SCHED; PG8_LDA(At, 1, 0); PG8_STAGE(PG8_SA(0, 1), a2 + hstep, voffA);
            PG8_WAIT_L(8); PG8_BAR; PG8_WAIT_L(0); PG8_MMA(0, 0, At, B0); PG8_BAR; PG8_SCHED;
            PG8_LDB(B1, 1, 1); PG8_STAGE(PG8_SB(1, 0), b3, voffB);
            PG8_BAR; PG8_WAIT_L(0); PG8_MMA(0, 1, At, B1); PG8_BAR;
            PG8_LDA(At, 1, 1); PG8_STAGE(PG8_SA(1, 0), a3, voffA);
            PG8_BAR; PG8_WAIT_L(0); PG8_MMA(1, 0, At, B0); PG8_BAR; PG8_SCHED;
            PG8_STAGE(PG8_SB(1, 1), b3 + hstep, voffB);
            PG8_WAIT_V(6); PG8_BAR; PG8_MMA(1, 1, At, B1); PG8_BAR;
            }
        }
        if constexpr (ALIGN_EPI) { if (wr == 0) PG8_BAR; }
        if constexpr (!Epi::AFTER_DRAIN) { E(acc, cur, wr, wc, fr, fq); S.done(cur); }
        if (!has_next) break;
#pragma unroll
        for (int a = 0; a < 2; ++a)
#pragma unroll
            for (int b = 0; b < 2; ++b)
#pragma unroll
                for (int m = 0; m < 4; ++m)
#pragma unroll
                    for (int n = 0; n < 2; ++n) acc[a][b][m][n] = (f32x4){0.f, 0.f, 0.f, 0.f};
        cur = nxt; cA = nA; cB = nB; ++ui;
        if constexpr (ALIGN_EPI) { if (wr == 1) PG8_BAR; }
    }
    PG8_WAIT_V(0);
    if constexpr (!ALIGN_EPI) { if (wr == 0) PG8_BAR; }
    PG8_BAR;
    if constexpr (Epi::AFTER_DRAIN) { E.fused(acc, cur, wr, wc, fr, fq, lds, wid, lane); S.done(cur); }
#undef PG8_SA
#undef PG8_SB
#undef PG8_STAGE
#undef PG8_LDA
#undef PG8_LDB
#undef PG8_MMA
#undef PG8_WAIT_V
#undef PG8_WAIT_L
#undef PG8_BAR
#undef PG8_SCHED
}
}

#define LAS __attribute__((address_space(3)))
typedef unsigned short bf16_t;
typedef short bf16x8 __attribute__((ext_vector_type(8)));
typedef short s16x4 __attribute__((ext_vector_type(4)));
typedef float f32x4 __attribute__((ext_vector_type(4)));
typedef float f32x16 __attribute__((ext_vector_type(16)));
typedef unsigned u32x4 __attribute__((ext_vector_type(4)));
typedef unsigned u32x2 __attribute__((ext_vector_type(2)));
using pg8::pkbf; using pg8::bflo; using pg8::bfhi;

struct Args { const float* in[26]; float* out; unsigned char* ws; };
typedef const __attribute__((address_space(4))) Args* ArgsP;

__device__ __forceinline__ float wave_sum(float v) {
#pragma unroll
    for (int o = 1; o < 64; o <<= 1) v += __shfl_xor(v, o);
    return v;
}
__device__ __forceinline__ int wave_sum_i(int v) {
    v += __builtin_amdgcn_update_dpp(0, v, 0x128, 0xf, 0xf, false);
    v += __builtin_amdgcn_update_dpp(0, v, 0x124, 0xf, 0xf, false);
    v += __builtin_amdgcn_update_dpp(0, v, 0x122, 0xf, 0xf, false);
    v += __builtin_amdgcn_update_dpp(0, v, 0x121, 0xf, 0xf, false);
    return __builtin_amdgcn_readlane(v, 0) + __builtin_amdgcn_readlane(v, 16) + __builtin_amdgcn_readlane(v, 32) + __builtin_amdgcn_readlane(v, 48);
}
__device__ __forceinline__ unsigned wave_or_u(unsigned v) {
    v |= (unsigned)__builtin_amdgcn_update_dpp(0, (int)v, 0x128, 0xf, 0xf, false);
    v |= (unsigned)__builtin_amdgcn_update_dpp(0, (int)v, 0x124, 0xf, 0xf, false);
    v |= (unsigned)__builtin_amdgcn_update_dpp(0, (int)v, 0x122, 0xf, 0xf, false);
    v |= (unsigned)__builtin_amdgcn_update_dpp(0, (int)v, 0x121, 0xf, 0xf, false);
    return (unsigned)(__builtin_amdgcn_readlane((int)v, 0) | __builtin_amdgcn_readlane((int)v, 16) | __builtin_amdgcn_readlane((int)v, 32) | __builtin_amdgcn_readlane((int)v, 48));
}
__device__ __forceinline__ void lds_wait() { asm volatile("s_waitcnt lgkmcnt(0)" ::: "memory"); }

__device__ __forceinline__ int rowmap(int mode, int n) {
    if (mode == 1) return 256 * (n >> 7) + (n & 127);
    if (mode == 2) return 256 * (n >> 7) + 128 + (n & 127);
    if (mode == 3) return n < 2120 ? n : n + 184;
    return n;
}
__device__ __forceinline__ void transpose_item(const float* W, int K, int N, bf16_t* WT, int mode, LAS float* scr, int item, int lane) {
    const int nblk = (N + 31) >> 5, kb = item / nblk, nb = item % nblk, k0 = 64 * kb, n0 = 32 * nb;
    { const int ch = lane & 7, nn = n0 + 4 * ch;
      f32x4 v[8];
#pragma unroll
      for (int i = 0; i < 8; ++i) { v[i] = (f32x4){0.f, 0.f, 0.f, 0.f}; if (nn < N) v[i] = *(const f32x4*)(W + (size_t)(k0 + 8 * i + (lane >> 3)) * N + nn); }
#pragma unroll
      for (int i = 0; i < 8; ++i) { LAS float* d = scr + (8 * i + (lane >> 3)) * 33 + 4 * ch; d[0] = v[i].x; d[1] = v[i].y; d[2] = v[i].z; d[3] = v[i].w; } }
    lds_wait();
    const int c = lane & 7;
#pragma unroll
    for (int j = 0; j < 4; ++j) { const int n = (lane >> 3) + 8 * j; const LAS float* s = scr + (8 * c) * 33 + n;
        u32x4 o; o.x = pkbf(s[0 * 33], s[1 * 33]); o.y = pkbf(s[2 * 33], s[3 * 33]); o.z = pkbf(s[4 * 33], s[5 * 33]); o.w = pkbf(s[6 * 33], s[7 * 33]);
        if (n0 + n < N) *(u32x4*)(WT + (size_t)rowmap(mode, n0 + n) * K + k0 + 8 * c) = o; }
    lds_wait();
}
__device__ __forceinline__ void cvt_row4(const float* src, bf16_t* dst) { const f32x4 v = *(const f32x4*)src; u32x2 w; w.x = pkbf(v.x, v.y); w.y = pkbf(v.z, v.w); *(u32x2*)dst = w; }

__device__ __forceinline__ void prologue(ArgsP a, LAS unsigned char* lds, int G) {
    int tid_ = threadIdx.x; asm volatile("" : "+v"(tid_)); const int tid = tid_, lane = tid & 63, wave = tid >> 6;
    const int gw = blockIdx.x * NWAVES + wave, NGW = G * NWAVES;
    LAS float* scr = (LAS float*)(lds + wave * 16384);
    unsigned char* ws = a->ws;
    constexpr int I_UP = 16 * 88, I_DN = 44 * 32, I_IN = 16 * 195, I_SQ = 16 * 32;
    constexpr int NITEMS = 4 * I_UP + 2 * I_DN + I_IN + 3 * I_SQ;
    for (int it = gw; it < NITEMS; it += NGW) {
        int r = it;
        if (r < I_UP) { transpose_item(a->in[8], 1024, FF, (bf16_t*)(ws + WS_W1U), 1, scr, r, lane); continue; } r -= I_UP;
        if (r < I_UP) { transpose_item(a->in[9], 1024, FF, (bf16_t*)(ws + WS_W1U), 2, scr, r, lane); continue; } r -= I_UP;
        if (r < I_UP) { transpose_item(a->in[21], 1024, FF, (bf16_t*)(ws + WS_W2U), 1, scr, r, lane); continue; } r -= I_UP;
        if (r < I_UP) { transpose_item(a->in[22], 1024, FF, (bf16_t*)(ws + WS_W2U), 2, scr, r, lane); continue; } r -= I_UP;
        if (r < I_DN) { transpose_item(a->in[10], FF, 1024, (bf16_t*)(ws + WS_W1D), 0, scr, r, lane); continue; } r -= I_DN;
        if (r < I_DN) { transpose_item(a->in[23], FF, 1024, (bf16_t*)(ws + WS_W2D), 0, scr, r, lane); continue; } r -= I_DN;
        if (r < I_IN) { transpose_item(a->in[11], 1024, WIN_SRC, (bf16_t*)(ws + WS_WIN), 3, scr, r, lane); continue; } r -= I_IN;
        if (r < I_SQ) { transpose_item(a->in[16], 1024, 1024, (bf16_t*)(ws + WS_WA), 0, scr, r, lane); continue; } r -= I_SQ;
        if (r < I_SQ) { transpose_item(a->in[17], 1024, 1024, (bf16_t*)(ws + WS_WB), 0, scr, r, lane); continue; } r -= I_SQ;
        transpose_item(a->in[18], 1024, 1024, (bf16_t*)(ws + WS_WO), 0, scr, r, lane);
    }
    bf16_t* xb = (bf16_t*)(ws + WS_XB);
    for (int m = gw; m < MT; m += NGW) {
        const float* src = m < MP ? a->in[0] + (size_t)m * 1024 : a->in[1] + (size_t)(m - MP) * 1024;
#pragma unroll
        for (int j = 0; j < 4; ++j) cvt_row4(src + 4 * lane + 256 * j, xb + (size_t)m * 1024 + 4 * lane + 256 * j);
    }
    bf16_t *ks = (bf16_t*)(ws + WS_KS), *vs = (bf16_t*)(ws + WS_VS), *kis = (bf16_t*)(ws + WS_KIS);
    for (int r = gw; r < 32 * 1024; r += NGW) { const int b = r >> 10, s = r & 1023; const size_t d = ((size_t)b * LTOT + s) * 256 + 4 * lane;
        cvt_row4(a->in[2] + (size_t)r * 256 + 4 * lane, ks + d); cvt_row4(a->in[3] + (size_t)r * 256 + 4 * lane, vs + d); }
    for (int r4 = gw; r4 < 32 * 1024 / 4; r4 += NGW) { const int r = 4 * r4 + (lane >> 4), b = r >> 10, s = r & 1023, c = 4 * (lane & 15);
        cvt_row4(a->in[4] + (size_t)r * 64 + c, kis + ((size_t)b * LTOT + s) * 64 + c); }
    const int gt = blockIdx.x * NTHREADS + tid, NGT = G * NTHREADS;
    bf16_t* wgm = (bf16_t*)(ws + WS_WGM);
    for (int idx = gt; idx < 4 * 128 * 128; idx += NGT) { const int i = (idx >> 7) & 127, j = idx & 127; const float v = j <= i ? a->in[14][idx] : 0.f; wgm[idx] = (bf16_t)(pkbf(v, 0.f) & 0xffffu); }
    u32x4* wz = (u32x4*)((bf16_t*)(ws + WS_WIN) + (size_t)2120 * 1024);
    for (int idx = gt; idx < 184 * 128; idx += NGT) wz[idx] = (u32x4){0u, 0u, 0u, 0u};
}

__device__ __forceinline__ void ln_phase(const bf16_t* in, const float* g, const float* b, bf16_t* ob, float* of, int G) {
    int tid_ = threadIdx.x; asm volatile("" : "+v"(tid_)); const int tid = tid_, lane = tid & 63, wave = tid >> 6;
    const int gw = blockIdx.x * NWAVES + wave, NGW = G * NWAVES;
    f32x4 gv[4], bv[4];
#pragma unroll
    for (int j = 0; j < 4; ++j) { gv[j] = *(const f32x4*)(g + 4 * lane + 256 * j); bv[j] = *(const f32x4*)(b + 4 * lane + 256 * j); }
    for (int m = gw; m < MT; m += NGW) {
        const bf16_t* xr = in + (size_t)m * 1024 + 4 * lane;
        f32x4 v[4]; float s = 0.f;
#pragma unroll
        for (int j = 0; j < 4; ++j) { const u32x2 w = *(const u32x2*)(xr + 256 * j); v[j] = (f32x4){bflo(w.x), bfhi(w.x), bflo(w.y), bfhi(w.y)}; s += (v[j].x + v[j].y) + (v[j].z + v[j].w); }
        const float mean = wave_sum(s) * (1.f / 1024.f); float s2 = 0.f;
#pragma unroll
        for (int j = 0; j < 4; ++j) { v[j] = v[j] - mean; s2 += (v[j].x * v[j].x + v[j].y * v[j].y) + (v[j].z * v[j].z + v[j].w * v[j].w); }
        const float rstd = 1.f / sqrtf(wave_sum(s2) * (1.f / 1024.f) + LN_EPS);
#pragma unroll
        for (int j = 0; j < 4; ++j) { const f32x4 o = v[j] * rstd * gv[j] + bv[j];
            if (ob) { u32x2 w; w.x = pkbf(o.x, o.y); w.y = pkbf(o.z, o.w); *(u32x2*)(ob + (size_t)m * 1024 + 4 * lane + 256 * j) = w; }
            if (of) *(f32x4*)(of + (size_t)m * 1024 + 4 * lane + 256 * j) = o; }
    }
}

typedef short v4i16_t __attribute__((ext_vector_type(4)));
__device__ __forceinline__ s16x4 tr_read(const LAS unsigned char* p) { return __builtin_bit_cast(s16x4, __builtin_amdgcn_ds_read_tr16_b64_v4i16((LAS v4i16_t*)p)); }
constexpr int GIMG_STRIDE = 544;
constexpr int LDS_AUX = 131072;

__device__ __forceinline__ void gate_unit(ArgsP a, LAS unsigned char* lds, int unit) {
    int tid_ = threadIdx.x; asm volatile("" : "+v"(tid_)); const int tid = tid_, lane = tid & 63, wave = __builtin_amdgcn_readfirstlane(tid >> 6);
    const bool samp = unit >= 512;
    const int m0 = samp ? MP + 16 * (unit - 512) : 128 * unit, nrows = samp ? 16 : 128;
    const bf16_t* vpre = (const bf16_t*)(a->ws + WS_VPRE); bf16_t* ub = (bf16_t*)(a->ws + WS_U); const bf16_t* wgm = (const bf16_t*)(a->ws + WS_WGM);
    const float *gmg = a->in[12], *gmb = a->in[13], *gbs = a->in[15];
    LAS float* ST = (LAS float*)(lds + LDS_AUX);
    for (int rr = 0; rr < 16; ++rr) { const int row = wave * 16 + rr;
        if (row < nrows) { const bf16_t* rp = vpre + (size_t)(m0 + row) * 1024 + 8 * lane;
            const u32x4 w0 = *(const u32x4*)rp, w1 = *(const u32x4*)(rp + 512);
            float x[16] = {bflo(w0.x), bfhi(w0.x), bflo(w0.y), bfhi(w0.y), bflo(w0.z), bfhi(w0.z), bflo(w0.w), bfhi(w0.w), bflo(w1.x), bfhi(w1.x), bflo(w1.y), bfhi(w1.y), bflo(w1.z), bfhi(w1.z), bflo(w1.w), bfhi(w1.w)};
            float s = 0.f;
#pragma unroll
            for (int e = 0; e < 16; ++e) s += x[e];
            const float mean = wave_sum(s) * (1.f / 1024.f); float s2 = 0.f;
#pragma unroll
            for (int e = 0; e < 16; ++e) { const float d = x[e] - mean; s2 += d * d; }
            const float rstd = 1.f / sqrtf(wave_sum(s2) * (1.f / 1024.f) + LN_EPS);
            if (lane == 0) { ST[2 * row] = mean; ST[2 * row + 1] = rstd; } } }
    __syncthreads();
    const int j16 = lane & 15, kq = lane >> 4;
    for (int g = 0; g < 4; ++g) {
        { const int col = 8 * (tid & 31);
          const f32x4 g0 = *(const f32x4*)(gmg + 256 * g + col), g1 = *(const f32x4*)(gmg + 256 * g + col + 4), b0 = *(const f32x4*)(gmb + 256 * g + col), b1 = *(const f32x4*)(gmb + 256 * g + col + 4);
          u32x4 xr[8];
#pragma unroll
          for (int it = 0; it < 8; ++it) { const int row = it * 16 + (tid >> 5); xr[it] = (u32x4){0u, 0u, 0u, 0u}; if (row < nrows) xr[it] = *(const u32x4*)(vpre + (size_t)(m0 + row) * 1024 + 256 * g + col); }
#pragma unroll
          for (int it = 0; it < 8; ++it) { const int row = it * 16 + (tid >> 5); const float mean = ST[2 * row], rstd = ST[2 * row + 1]; u32x4 w = (u32x4){0u, 0u, 0u, 0u};
              if (row < nrows) { const u32x4 x = xr[it];
                  f32x4 y0 = (f32x4){bflo(x.x), bfhi(x.x), bflo(x.y), bfhi(x.y)}, y1 = (f32x4){bflo(x.z), bfhi(x.z), bflo(x.w), bfhi(x.w)};
                  y0 = (y0 - mean) * rstd * g0 + b0; y1 = (y1 - mean) * rstd * g1 + b1;
                  w.x = pkbf(y0.x, y0.y); w.y = pkbf(y0.z, y0.w); w.z = pkbf(y1.x, y1.y); w.w = pkbf(y1.z, y1.w);
                  if (samp) { float* o = a->out + O_GV + (size_t)(m0 - MP + row) * 1024 + 256 * g + col; *(f32x4*)o = y0; *(f32x4*)(o + 4) = y1; } }
              *(LAS u32x4*)(lds + row * GIMG_STRIDE + col * 2) = w; } }
        __syncthreads();
        const int ib = 32 * (wave & 3), cb = 128 * (wave >> 2);
        f32x4 acc[2][8];
#pragma unroll
        for (int it = 0; it < 2; ++it)
#pragma unroll
            for (int ct = 0; ct < 8; ++ct) acc[it][ct] = (f32x4){0.f, 0.f, 0.f, 0.f};
#pragma unroll
        for (int ks = 0; ks < 4; ++ks) if (ks <= (wave & 3)) {
            bf16x8 wf[2];
#pragma unroll
            for (int it = 0; it < 2; ++it) wf[it] = *(const bf16x8*)(wgm + (size_t)g * 16384 + (ib + 16 * it + j16) * 128 + 32 * ks + 8 * kq);
#pragma unroll
            for (int ct = 0; ct < 8; ++ct) {
                const LAS unsigned char* p = lds + (32 * ks + 8 * kq + (j16 >> 2)) * GIMG_STRIDE + (cb + 16 * ct + 4 * (j16 & 3)) * 2;
                const s16x4 lo = tr_read(p), hi = tr_read(p + 4 * GIMG_STRIDE);
                const bf16x8 vf = (bf16x8){lo[0], lo[1], lo[2], lo[3], hi[0], hi[1], hi[2], hi[3]};
#pragma unroll
                for (int it = 0; it < 2; ++it) acc[it][ct] = __builtin_amdgcn_mfma_f32_16x16x32_bf16(vf, wf[it], acc[it][ct], 0, 0, 0);
            }
        }
#pragma unroll
        for (int it = 0; it < 2; ++it) { const int i = ib + 16 * it + j16;
            if (i < nrows) { const float bsv = gbs[g * 128 + i];
#pragma unroll
                for (int ct = 0; ct < 8; ++ct) { bf16_t* up = ub + (size_t)(m0 + i) * 1024 + 256 * g + cb + 16 * ct + 4 * kq;
                    const u32x2 uu = *(const u32x2*)up; const f32x4 s = acc[it][ct] + bsv; u32x2 w;
                    w.x = pkbf(bflo(uu.x) * s.x, bfhi(uu.x) * s.y); w.y = pkbf(bflo(uu.y) * s.z, bfhi(uu.y) * s.w); *(u32x2*)up = w; } } }
        __syncthreads();
    }
}

constexpr int VST_STRIDE = 288, VST_BYTES = 32 * VST_STRIDE;
__device__ __forceinline__ unsigned f2key(float f) { const unsigned u = __float_as_uint(f); return u ^ ((unsigned)((int)u >> 31) | 0x80000000u); }
__device__ __forceinline__ unsigned sel_entry(int s, int qpos) {
    const int rel = s - qpos, n = rel < 0 ? -rel : rel;
    const int large = 8 + (n >= 12) + (n >= 16) + (n >= 23) + (n >= 32) + (n >= 46) + (n >= 64) + (n >= 91);
    const int bk = (rel > 0 ? 16 : 0) + (n < 8 ? n : large);
    return (unsigned)s | ((unsigned)bk << 16) | (1u << 24);
}

#define TRANSPOSE32(K0) do { \
    _Pragma("unroll") for (int k = 0; k < 16; ++k) { const unsigned x = key[(K0) + k], y = key[(K0) + k + 16]; \
        key[(K0) + k] = __builtin_amdgcn_perm(y, x, 0x05040100u); key[(K0) + k + 16] = __builtin_amdgcn_perm(y, x, 0x07060302u); } \
    _Pragma("unroll") for (int k = 0; k < 32; ++k) if ((k & 8) == 0) { const unsigned x = key[(K0) + k], y = key[(K0) + k + 8]; \
        key[(K0) + k] = __builtin_amdgcn_perm(y, x, 0x06020400u); key[(K0) + k + 8] = __builtin_amdgcn_perm(y, x, 0x07030501u); } \
    _Pragma("unroll") for (int k = 0; k < 32; ++k) if ((k & 4) == 0) { const unsigned x = key[(K0) + k], y = key[(K0) + k + 4]; \
        key[(K0) + k] = (x & 0x0f0f0f0fu) | ((y << 4) & 0xf0f0f0f0u); key[(K0) + k + 4] = ((x >> 4) & 0x0f0f0f0fu) | (y & 0xf0f0f0f0u); } \
    _Pragma("unroll") for (int k = 0; k < 32; ++k) if ((k & 2) == 0) { const unsigned x = key[(K0) + k], y = key[(K0) + k + 2]; \
        key[(K0) + k] = (x & 0x33333333u) | ((y << 2) & 0xccccccccu); key[(K0) + k + 2] = ((x >> 2) & 0x33333333u) | (y & 0xccccccccu); } \
    _Pragma("unroll") for (int k = 0; k < 32; ++k) if ((k & 1) == 0) { const unsigned x = key[(K0) + k], y = key[(K0) + k + 1]; \
        key[(K0) + k] = (x & 0x55555555u) | ((y << 1) & 0xaaaaaaaau); key[(K0) + k + 1] = ((x >> 1) & 0x55555555u) | (y & 0xaaaaaaaau); } } while (0)

__device__ __forceinline__ void sel_unit(ArgsP a, LAS unsigned char* lds, int unit) {
    int tid_ = threadIdx.x; asm volatile("" : "+v"(tid_)); const int tid = tid_, lane = tid & 63, wave = __builtin_amdgcn_readfirstlane(tid >> 6);
    int m0, nvis, qpos0; const bf16_t* Kib;
    if (unit < 64) { const int b = unit >> 1, i0 = (unit & 1) * 8; m0 = MP + b * 16 + i0; nvis = LTOT; qpos0 = 1024 + i0; Kib = (const bf16_t*)(a->ws + WS_KIS) + (size_t)b * LTOT * 64; }
    else { const int u = unit - 64, b = u >> 10, t0 = (u & 1023) * 8; m0 = b * SEQ + t0; nvis = ((t0 >> 6) + 1) * 64; qpos0 = t0; Kib = (const bf16_t*)(a->ws + WS_KIP) + (size_t)b * SEQ * 64; }
    const bf16_t* qib = (const bf16_t*)(a->ws + WS_QI); const float* wib = (const float*)(a->ws + WS_WI);
    LAS float* SC = (LAS float*)lds;
    LAS unsigned* SEL = (LAS unsigned*)(lds + LDS_AUX);
    LAS unsigned* sel = SEL + wave * 256; const LAS float* sc = SC + wave * 4096; const int qpos = qpos0 + wave;
    const int j = lane & 15, kq = lane >> 4;
    unsigned key[128];

    bf16x8 af[2][2][2];
    { const int tq = j >> 2;
#pragma unroll
      for (int qg = 0; qg < 2; ++qg)
#pragma unroll
        for (int mt = 0; mt < 2; ++mt) { const int hh = 4 * mt + (j & 3); const size_t mq = (size_t)(m0 + 4 * qg + tq); const float wabs = fabsf(wib[mq * 8 + hh]);
#pragma unroll
          for (int ks = 0; ks < 2; ++ks) { const u32x4 w = *(const u32x4*)(qib + mq * 512 + hh * 64 + 32 * ks + 8 * kq);
              u32x4 o; o.x = pkbf(bflo(w.x) * wabs, bfhi(w.x) * wabs); o.y = pkbf(bflo(w.y) * wabs, bfhi(w.y) * wabs); o.z = pkbf(bflo(w.z) * wabs, bfhi(w.z) * wabs); o.w = pkbf(bflo(w.w) * wabs, bfhi(w.w) * wabs);
              af[qg][mt][ks] = __builtin_bit_cast(bf16x8, o); } } }
    float sg[2][8];
#pragma unroll
    for (int qg = 0; qg < 2; ++qg)
#pragma unroll
        for (int r4 = 0; r4 < 2; ++r4) { const f32x4 w = *(const f32x4*)(wib + (size_t)(m0 + 4 * qg + kq) * 8 + 4 * r4);
#pragma unroll
            for (int e = 0; e < 4; ++e) sg[qg][4 * r4 + e] = w[e] > 0.f ? 1.f : (w[e] < 0.f ? -1.f : 0.f); }

    LAS unsigned char* stg = lds + LDS_AUX + 8192 + wave * 2304;
#define SC_LOAD(dst, tile) do { const bf16_t* kp_ = Kib + (size_t)((tile) * 32 + (lane >> 3)) * 64 + 8 * (lane & 7); \
        dst[0] = *(const bf16x8*)kp_; dst[1] = *(const bf16x8*)(kp_ + 8 * 64); dst[2] = *(const bf16x8*)(kp_ + 16 * 64); dst[3] = *(const bf16x8*)(kp_ + 24 * 64); } while (0)
#define SC_TILE(src, tloc) do { _Pragma("unroll") for (int c = 0; c < 2; ++c) { \
        *(LAS bf16x8*)(stg + (lane >> 3) * 144 + (lane & 7) * 16) = src[2 * c]; *(LAS bf16x8*)(stg + (8 + (lane >> 3)) * 144 + (lane & 7) * 16) = src[2 * c + 1]; \
        asm volatile("" ::: "memory"); __builtin_amdgcn_wave_barrier(); \
        const bf16x8 f0 = *(const LAS bf16x8*)(stg + j * 144 + 16 * kq), f1 = *(const LAS bf16x8*)(stg + j * 144 + 64 + 16 * kq); \
        asm volatile("" ::: "memory"); __builtin_amdgcn_wave_barrier(); \
        _Pragma("unroll") for (int qg = 0; qg < 2; ++qg) { \
        f32x4 d0 = (f32x4){0.f, 0.f, 0.f, 0.f}, d1 = (f32x4){0.f, 0.f, 0.f, 0.f}; \
        d0 = __builtin_amdgcn_mfma_f32_16x16x32_bf16(af[qg][0][0], f0, d0, 0, 0, 0); d1 = __builtin_amdgcn_mfma_f32_16x16x32_bf16(af[qg][1][0], f0, d1, 0, 0, 0); \
        d0 = __builtin_amdgcn_mfma_f32_16x16x32_bf16(af[qg][0][1], f1, d0, 0, 0, 0); d1 = __builtin_amdgcn_mfma_f32_16x16x32_bf16(af[qg][1][1], f1, d1, 0, 0, 0); \
        float sa = 0.f, sb = 0.f; \
        _Pragma("unroll") for (int r = 0; r < 4; ++r) { sa += sg[qg][r] * fmaxf(d0[r], 0.f); sb += sg[qg][4 + r] * fmaxf(d1[r], 0.f); } \
        SC[(4 * qg + kq) * 4096 + (tloc) * 32 + 16 * c + j] = sa + sb; } } } while (0)
#pragma unroll
    for (int half = 0; half < 2; ++half) {
        if (half * 4096 < nvis) {
            const int khi = nvis < half * 4096 + 4096 ? nvis : half * 4096 + 4096, ntiles = (khi - half * 4096 + 31) >> 5, tbase = half * 128;
            bf16x8 b0[4], b1[4], b2[4], b3[4];
            const int nk = (ntiles - wave + NWAVES - 1) / NWAVES;
            if (nk > 0) {
#define TLOC(k) (wave + NWAVES * ((k) < nk ? (k) : nk - 1))
                SC_LOAD(b0, tbase + TLOC(0)); SC_LOAD(b1, tbase + TLOC(1)); SC_LOAD(b2, tbase + TLOC(2)); __builtin_amdgcn_sched_barrier(0);
                for (int k = 0; k < nk; k += 4) {
                    SC_LOAD(b3, tbase + TLOC(k + 3)); __builtin_amdgcn_sched_barrier(0);
                    SC_TILE(b0, TLOC(k)); __builtin_amdgcn_sched_barrier(0);
                    SC_LOAD(b0, tbase + TLOC(k + 4)); __builtin_amdgcn_sched_barrier(0);
                    if (k + 1 < nk) SC_TILE(b1, TLOC(k + 1));
                    __builtin_amdgcn_sched_barrier(0);
                    SC_LOAD(b1, tbase + TLOC(k + 5)); __builtin_amdgcn_sched_barrier(0);
                    if (k + 2 < nk) SC_TILE(b2, TLOC(k + 2));
                    __builtin_amdgcn_sched_barrier(0);
                    SC_LOAD(b2, tbase + TLOC(k + 6)); __builtin_amdgcn_sched_barrier(0);
                    if (k + 3 < nk) SC_TILE(b3, TLOC(k + 3));
                    __builtin_amdgcn_sched_barrier(0);
                }
#undef TLOC
            }
            __syncthreads();
            if (nvis > 256) {
#pragma unroll
                for (int wb = 0; wb < 2; ++wb) {
                    const int w = 2 * half + wb;
                    if (w * 2048 < nvis) {
#pragma unroll
                        for (int k = 0; k < 32; ++k) key[32 * w + k] = f2key(sc[(32 * wb + k) * 64 + lane]);
                        TRANSPOSE32(32 * w);
                    } else {
#pragma unroll
                        for (int k = 0; k < 32; ++k) key[32 * w + k] = 0u;
                    }
                    __builtin_amdgcn_sched_barrier(0);
                }
            }
            if (half == 0 && nvis > 4096) __syncthreads();
        } else {
#pragma unroll
            for (int k = 0; k < 64; ++k) key[64 * half + k] = 0u;
        }
    }
#undef SC_LOAD
#undef SC_TILE
    if (nvis <= 256) { for (int p = lane; p < 256; p += 64) sel[p] = p < nvis ? sel_entry(p, qpos) : 0u; }
    else {
        unsigned A[4], GT[4];
        { const int nsl = (nvis - lane + 63) >> 6;
#pragma unroll
          for (int w = 0; w < 4; ++w) { const int r = nsl - 32 * w; A[w] = r >= 32 ? 0xffffffffu : (r > 0 ? ((1u << r) - 1u) : 0u); GT[w] = 0u; } }
        int cabove = 0; bool done = false;
#pragma unroll
        for (int bit = 31; bit >= 0; --bit) {
            if (!done) {
                unsigned ones[4]; int c = 0;
#pragma unroll
                for (int w = 0; w < 4; ++w) { ones[w] = A[w] & key[32 * w + bit]; c += __builtin_popcount(ones[w]); }
                const int tot = cabove + wave_sum_i(c);
                if (tot >= 256) {
#pragma unroll
                    for (int w = 0; w < 4; ++w) A[w] = ones[w];
                    if (tot == 256) {
#pragma unroll
                        for (int w = 0; w < 4; ++w) { GT[w] |= ones[w]; A[w] = 0u; }
                        cabove = 256; done = true; }
                } else {
#pragma unroll
                    for (int w = 0; w < 4; ++w) { GT[w] |= ones[w]; A[w] &= ~key[32 * w + bit]; }
                    cabove = tot; }
            }
        }
        const int cgt = cabove, need_eq = 256 - cgt;
        { int cl = 0;
#pragma unroll
          for (int w = 0; w < 4; ++w) cl += __builtin_popcount(GT[w]);
          int x = cl;
#pragma unroll
          for (int d = 1; d < 64; d <<= 1) { const int v = __shfl_up(x, d); if (lane >= d) x += v; }
          int pos = x - cl;
#pragma unroll
          for (int w = 0; w < 4; ++w) { unsigned mk = GT[w];
              while (mk) { const int i = __builtin_ctz(mk); mk &= mk - 1u; sel[pos++] = (unsigned)((32 * w + i) * 64 + lane); } } }
        if (need_eq > 0) { int base_eq = 0;
#pragma unroll
            for (int w = 0; w < 4; ++w) { unsigned U = wave_or_u(A[w]);
                while (U != 0u && base_eq < need_eq) { const int i = __builtin_ctz(U); U &= U - 1u;
                    const bool eq = (A[w] >> i) & 1u; const unsigned long long be = __ballot(eq);
                    const int re = base_eq + (int)__builtin_amdgcn_mbcnt_hi((unsigned)(be >> 32), __builtin_amdgcn_mbcnt_lo((unsigned)be, 0u));
                    if (eq && re < need_eq) sel[cgt + re] = (unsigned)((32 * w + i) * 64 + lane);
                    base_eq += __popcll(be); } } }
        lds_wait();
        { u32x4 e4 = *(LAS u32x4*)(sel + 4 * lane);
#pragma unroll
          for (int r = 0; r < 4; ++r) e4[r] = sel_entry((int)e4[r], qpos);
          *(LAS u32x4*)(sel + 4 * lane) = e4; }
    }
    { lds_wait(); unsigned* sg_ = (unsigned*)(a->ws + WS_SEL) + (size_t)(m0 + wave) * 256; *(u32x4*)(sg_ + 4 * lane) = *(const LAS u32x4*)(sel + 4 * lane); }
    __syncthreads();
}
#undef TRANSPOSE32

__device__ __forceinline__ float att_red_max(float v) {
    v = fmaxf(v, __int_as_float(__builtin_amdgcn_update_dpp(0, __float_as_int(v), 0x124, 0xf, 0xf, false)));
    v = fmaxf(v, __int_as_float(__builtin_amdgcn_update_dpp(0, __float_as_int(v), 0x128, 0xf, 0xf, false)));
    { auto r = __builtin_amdgcn_permlane16_swap(__float_as_uint(v), __float_as_uint(v), false, false); v = fmaxf(__uint_as_float(r[0]), __uint_as_float(r[1])); }
    { auto r = __builtin_amdgcn_permlane32_swap(__float_as_uint(v), __float_as_uint(v), false, false); v = fmaxf(__uint_as_float(r[0]), __uint_as_float(r[1])); }
    return v;
}
__device__ __forceinline__ float att_red_sum(float v) {
    v += __int_as_float(__builtin_amdgcn_update_dpp(0, __float_as_int(v), 0x124, 0xf, 0xf, false));
    v += __int_as_float(__builtin_amdgcn_update_dpp(0, __float_as_int(v), 0x128, 0xf, 0xf, false));
    { auto r = __builtin_amdgcn_permlane16_swap(__float_as_uint(v), __float_as_uint(v), false, false); v = __uint_as_float(r[0]) + __uint_as_float(r[1]); }
    { auto r = __builtin_amdgcn_permlane32_swap(__float_as_uint(v), __float_as_uint(v), false, false); v = __uint_as_float(r[0]) + __uint_as_float(r[1]); }
    return v;
}
constexpr int ATT_WAVE_LDS = 1024 + 32 * 160;
__device__ __forceinline__ void att_unit(ArgsP a, LAS unsigned char* lds, int qblk, int kvh) {
    int tid_ = threadIdx.x; asm volatile("" : "+v"(tid_)); const int tid = tid_, lane = tid & 63, wave = __builtin_amdgcn_readfirstlane(tid >> 6);
    const int m = qblk * 8 + wave;
    const bf16_t *Kb, *Vb;
    if (m < MP) { const int b = m >> 13; Kb = (const bf16_t*)(a->ws + WS_KP) + (size_t)b * SEQ * 256; Vb = (const bf16_t*)(a->ws + WS_VP) + (size_t)b * SEQ * 256; }
    else { const int b = (m - MP) >> 4; Kb = (const bf16_t*)(a->ws + WS_KS) + (size_t)b * LTOT * 256; Vb = (const bf16_t*)(a->ws + WS_VS) + (size_t)b * LTOT * 256; }
    Kb += kvh * 64; Vb += kvh * 64;
    bf16_t* qb = (bf16_t*)(a->ws + WS_Q);
    LAS unsigned* sel = (LAS unsigned*)(lds + wave * ATT_WAVE_LDS);
    LAS unsigned char* vst = lds + wave * ATT_WAVE_LDS + 1024;
    const LAS float* REL = (const LAS float*)(lds + LDS_AUX + 4096);
    const int j = lane & 15, kq = lane >> 4;
    { const u32x4 e = *(const u32x4*)((const unsigned*)(a->ws + WS_SEL) + (size_t)m * 256 + 4 * lane); *(LAS u32x4*)(sel + 4 * lane) = e; }
    bf16x8 qf[2];
#pragma unroll
    for (int ks = 0; ks < 2; ++ks) { u32x4 w = (u32x4){0u, 0u, 0u, 0u};
        if (j < 4) w = *(const u32x4*)(qb + (size_t)m * 1024 + (kvh * 4 + j) * 64 + 32 * ks + 8 * kq);
        qf[ks] = __builtin_bit_cast(bf16x8, w); }
    lds_wait(); __builtin_amdgcn_wave_barrier();
    f32x4 S[16];
    {
        u32x4 kr[4][4];
#pragma unroll
        for (int s = 0; s < 3; ++s)
#pragma unroll
            for (int c = 0; c < 4; ++c) { const unsigned e = sel[32 * s + 8 * c + (lane >> 3)]; kr[s][c] = *(const u32x4*)((const char*)Kb + ((e & 0xffffu) * 512u + 16u * (unsigned)(lane & 7))); }
        __builtin_amdgcn_sched_barrier(0);
#pragma unroll
        for (int s = 0; s < 8; ++s) {
            if (s + 3 < 8) {
#pragma unroll
                for (int c = 0; c < 4; ++c) { const unsigned e = sel[32 * (s + 3) + 8 * c + (lane >> 3)]; kr[(s + 3) & 3][c] = *(const u32x4*)((const char*)Kb + ((e & 0xffffu) * 512u + 16u * (unsigned)(lane & 7))); }
            }
            __builtin_amdgcn_sched_barrier(0);
#pragma unroll
            for (int c = 0; c < 4; ++c) *(LAS u32x4*)(vst + (8 * c + (lane >> 3)) * 160 + (lane & 7) * 16) = kr[s & 3][c];
            asm volatile("" ::: "memory"); __builtin_amdgcn_wave_barrier();
#pragma unroll
            for (int tt = 0; tt < 2; ++tt) { const LAS unsigned char* p = vst + (16 * tt + j) * 160 + 16 * kq;
                const bf16x8 k0 = *(const LAS bf16x8*)p, k1 = *(const LAS bf16x8*)(p + 64);
                f32x4 sacc = (f32x4){0.f, 0.f, 0.f, 0.f};
                sacc = __builtin_amdgcn_mfma_f32_16x16x32_bf16(k0, qf[0], sacc, 0, 0, 0);
                sacc = __builtin_amdgcn_mfma_f32_16x16x32_bf16(k1, qf[1], sacc, 0, 0, 0);
                S[2 * s + tt] = sacc; }
            asm volatile("" ::: "memory"); __builtin_amdgcn_wave_barrier();
        }
    }
    u32x4 vr[4][4];
#pragma unroll
    for (int s = 0; s < 3; ++s)
#pragma unroll
        for (int c = 0; c < 4; ++c) { const unsigned e = sel[32 * s + 8 * c + (lane >> 3)]; vr[s][c] = *(const u32x4*)((const char*)Vb + ((e & 0xffffu) * 512u + 16u * (unsigned)(lane & 7))); }
    __builtin_amdgcn_sched_barrier(0);
    float L[16]; float mx = -3.0e38f;
#pragma unroll
    for (int t = 0; t < 16; ++t) {
        int pk = __float_as_int(S[t][0]);
        pk = __builtin_amdgcn_update_dpp(pk, __float_as_int(S[t][1]), 0x114, 0xf, 0x2, false);
        pk = __builtin_amdgcn_update_dpp(pk, __float_as_int(S[t][2]), 0x118, 0xf, 0x4, false);
        pk = __builtin_amdgcn_update_dpp(pk, __float_as_int(S[t][3]), 0x11c, 0xf, 0x8, false);
        const unsigned e = sel[16 * t + 4 * kq + (j >> 2)];
        const float bias = REL[((e >> 16) & 31u) * 16 + kvh * 4 + (j & 3)];
        const float l = (e >> 24) ? __int_as_float(pk) * 0.125f + bias : -1e30f; L[t] = l; mx = fmaxf(mx, l); }
    mx = att_red_max(mx);
    float sum = 0.f;
#pragma unroll
    for (int t = 0; t < 16; ++t) { const float p = __expf(L[t] - mx); L[t] = p; sum += p; }
    sum = att_red_sum(sum);
    bf16x8 pf[8];
#pragma unroll
    for (int s = 0; s < 8; ++s) { float P[2][4];
#pragma unroll
        for (int tt = 0; tt < 2; ++tt) { const int v = __float_as_int(L[2 * s + tt]);
            P[tt][0] = __int_as_float(j < 4 ? v : 0);
            P[tt][1] = __int_as_float(__builtin_amdgcn_update_dpp(0, v, 0x104, 0xf, 0x1, true));
            P[tt][2] = __int_as_float(__builtin_amdgcn_update_dpp(0, v, 0x108, 0xf, 0x1, true));
            P[tt][3] = __int_as_float(__builtin_amdgcn_update_dpp(0, v, 0x10c, 0xf, 0x1, true)); }
        u32x4 w; w.x = pkbf(P[0][0], P[0][1]); w.y = pkbf(P[0][2], P[0][3]); w.z = pkbf(P[1][0], P[1][1]); w.w = pkbf(P[1][2], P[1][3]);
        pf[s] = __builtin_bit_cast(bf16x8, w); }
    f32x4 O[4];
#pragma unroll
    for (int dt = 0; dt < 4; ++dt) O[dt] = (f32x4){0.f, 0.f, 0.f, 0.f};
#pragma unroll
    for (int s = 0; s < 8; ++s) {
        if (s + 3 < 8) {
#pragma unroll
            for (int c = 0; c < 4; ++c) { const unsigned e = sel[32 * (s + 3) + 8 * c + (lane >> 3)]; vr[(s + 3) & 3][c] = *(const u32x4*)((const char*)Vb + ((e & 0xffffu) * 512u + 16u * (unsigned)(lane & 7))); }
        }
        __builtin_amdgcn_sched_barrier(0);
#pragma unroll
        for (int c = 0; c < 4; ++c) *(LAS u32x4*)(vst + (8 * c + (lane >> 3)) * 160 + (lane & 7) * 16) = vr[s & 3][c];
        asm volatile("" ::: "memory"); __builtin_amdgcn_wave_barrier();
#pragma unroll
        for (int dt = 0; dt < 4; ++dt) { const LAS unsigned char* p = vst + (4 * kq + (j >> 2)) * 160 + (16 * dt + 4 * (j & 3)) * 2;
            const s16x4 lo = tr_read(p), hi = tr_read(p + 16 * 160);
            const bf16x8 vf = (bf16x8){lo[0], lo[1], lo[2], lo[3], hi[0], hi[1], hi[2], hi[3]};
            O[dt] = __builtin_amdgcn_mfma_f32_16x16x32_bf16(pf[s], vf, O[dt], 0, 0, 0); }
        asm volatile("" ::: "memory"); __builtin_amdgcn_wave_barrier();
    }
    float inv[4];
#pragma unroll
    for (int r = 0; r < 4; ++r) inv[r] = 1.0f / __shfl(sum, r);
    if (kq == 0) {
#pragma unroll
        for (int r = 0; r < 4; ++r) { bf16_t* op = qb + (size_t)m * 1024 + (kvh * 4 + r) * 64 + j;
#pragma unroll
            for (int dt = 0; dt < 4; ++dt) op[16 * dt] = (bf16_t)(pkbf(O[dt][r] * inv[r], 0.f) & 0xffffu); }
    }
}

#define XB_TMO      128
#define XB_XCNT(j)  (256  + 64 * (j))
#define XB_XSUB(j)  (1280 + 64 * (j))
#define XB_XGEN(j)  (2304 + 64 * (j))
#define XB_TOP      3328
#define XB_TOPGEN   3392
#define XCD_BAR_WORDS 3456
#define XB_SPIN_CAP (1u << 18)

__device__ __forceinline__ unsigned xb_ld(unsigned* p)              { return __hip_atomic_load(p, __ATOMIC_RELAXED, __HIP_MEMORY_SCOPE_AGENT); }
__device__ __forceinline__ unsigned xb_add(unsigned* p, unsigned v) { return __hip_atomic_fetch_add(p, v, __ATOMIC_RELAXED, __HIP_MEMORY_SCOPE_AGENT); }
__device__ __forceinline__ unsigned xb_xcc_id() { return (unsigned)__builtin_amdgcn_s_getreg((3 << 11) | 20) & 0xFu; }
#define XB_SPIN(cond, bar) do { unsigned _sp = 0; while (cond) { __builtin_amdgcn_s_sleep(1); \
    if ((++_sp & 255u) == 0u) { if (xb_ld(&(bar)[XB_TMO])) break; if (_sp > XB_SPIN_CAP) { atomicAdd(&(bar)[XB_TMO], 1u); break; } } } } while (0)

struct XcdBarrier {
    unsigned* bar; unsigned x;
    volatile LAS unsigned* st;
};

__device__ __forceinline__ XcdBarrier xcd_barrier_post(unsigned* bar, volatile LAS unsigned* st) {
    XcdBarrier b; b.bar = bar; b.x = xb_xcc_id(); b.st = st;
    if (threadIdx.x == 0) (void)xb_add(&bar[XB_XCNT(b.x)], 1u);
    return b;
}
__device__ __forceinline__ void xcd_barrier_complete(unsigned* bar, unsigned x, unsigned& nloc, unsigned& nx) {
    const unsigned G = gridDim.x * gridDim.y * gridDim.z;
    unsigned sum, cnt, mine, sp = 0u;
    for (;;) {
        sum = 0u; cnt = 0u; mine = 0u;
#pragma unroll
        for (unsigned j = 0; j < 16; ++j) { const unsigned c = xb_ld(&bar[XB_XCNT(j)]); sum += c; cnt += (c > 0u) ? 1u : 0u; mine = (j == x) ? c : mine; }
        if (sum == G) break;
        __builtin_amdgcn_s_sleep(1);
        if ((++sp & 255u) == 0u) { if (xb_ld(&bar[XB_TMO])) break; if (sp > XB_SPIN_CAP) { atomicAdd(&bar[XB_TMO], 1u); break; } }
    }
    nloc = mine > 0u ? mine : 1u; nx = cnt > 0u ? cnt : 1u;
}

__device__ __forceinline__ void xcd_barrier(const XcdBarrier& b) {
    asm volatile("s_waitcnt vmcnt(0)" ::: "memory");
    __syncthreads();
    if (threadIdx.x == 0) {
        unsigned* bar = b.bar;
        __builtin_amdgcn_s_waitcnt(0);
        unsigned nloc = b.st[0], nx = b.st[1];
        if (nloc == 0u) { xcd_barrier_complete(bar, b.x, nloc, nx); b.st[0] = nloc; b.st[1] = nx; }
        const unsigned old = xb_add(&bar[XB_XSUB(b.x)], 1u);
        const unsigned gen = old / nloc;
        if (old + 1u == (gen + 1u) * nloc) {
            __builtin_amdgcn_fence(__ATOMIC_RELEASE, "agent");
            asm volatile("s_waitcnt vmcnt(0)" ::: "memory");
            const unsigned og = xb_add(&bar[XB_TOP], 1u);
            const unsigned tg = og / nx;
            if (og + 1u == (tg + 1u) * nx) xb_add(&bar[XB_TOPGEN], 1u);
            else XB_SPIN(xb_ld(&bar[XB_TOPGEN]) == tg, bar);
            __builtin_amdgcn_fence(__ATOMIC_ACQUIRE, "agent");
            xb_add(&bar[XB_XGEN(b.x)], 1u);
            asm volatile("s_waitcnt vmcnt(0)" ::: "memory");
        } else {
            XB_SPIN(xb_ld(&bar[XB_XGEN(b.x)]) == gen, bar);
            __builtin_amdgcn_fence(__ATOMIC_ACQUIRE, "agent");
            asm volatile("s_waitcnt vmcnt(0)" ::: "memory");
        }
    }
    __syncthreads();
}

__global__ void __launch_bounds__(NTHREADS, 2) fwd_megakernel(Args args_unused) {
    extern __shared__ __attribute__((aligned(16))) unsigned char lds_raw[];
    LAS unsigned char* lds = (LAS unsigned char*)lds_raw;
    cg::grid_group grid = cg::this_grid();
    const int G = gridDim.x, tid = threadIdx.x;
    ArgsP ap = (ArgsP)__builtin_amdgcn_kernarg_segment_ptr();
    unsigned char* ws; float* out;
#define FRESH() do { asm volatile("" : "+s"(ap)); ws = ap->ws; out = ap->out; } while (0)
#define args (*ap)
#define ARGP ap
    FRESH();
    volatile LAS unsigned* bst = (volatile LAS unsigned*)(lds + LDS_BYTES - 64);
    if (tid < 2) bst[tid] = 0u;
    if (blockIdx.x == 0) for (int i = tid; i < XCD_BAR_WORDS; i += NTHREADS) ((unsigned*)(ws + WS_BAR))[i] = 0u;
#ifndef PHM
#define PHM 0xffff
#endif
#define HAS(k) ((PHM >> (k)) & 1)
#define GEMM_UP(Aptr, Woff) do { if (HAS(1)) { pg8::Gemm g{Aptr, (const bf16_t*)(ws + (Woff)), MT, NUP, 1024}; pg8::StaticOrder S; S.init(MT, NUP, G, (int)blockIdx.x); \
        pg8::EpiUp E{(bf16_t*)(ws + WS_HID)}; pg8::gemm_phase<pg8::EpiUp, pg8::StaticOrder, true, true>(lds, g, S, E); } } while (0)
#define GEMM_DOWN(Aptr, Woff, KK, RESB, SCALE, PREOFF) do { if (HAS(2)) { pg8::Gemm g{Aptr, (const bf16_t*)(ws + (Woff)), MT, 1024, KK}; pg8::StaticOrder S; S.init(MT, 1024, G, (int)blockIdx.x); \
        pg8::EpiDown E{(bf16_t*)(ws + (PREOFF)), args.in[0], args.in[1], RESB, SCALE}; pg8::gemm_phase<pg8::EpiDown, pg8::StaticOrder, true, true>(lds, g, S, E); } } while (0)
#define GEMM_BR(Aptr, Woff, GATE, MODE) do { if (HAS(7)) { pg8::Gemm g{Aptr, (const bf16_t*)(ws + (Woff)), MT, 1024, 1024}; pg8::StaticOrder S; S.init(MT, 1024, G, (int)blockIdx.x); \
        pg8::EpiBr E{(bf16_t*)(ws + WS_VPRE), GATE, MODE}; pg8::gemm_phase<pg8::EpiBr, pg8::StaticOrder, true, true>(lds, g, S, E); } } while (0)
    if (HAS(0)) prologue(ap, lds, G);
    grid.sync(); FRESH();
    XcdBarrier xbar = xcd_barrier_post((unsigned*)(ws + WS_BAR), bst);
#define GSYNC() do { xbar.bar = (unsigned*)(ws + WS_BAR); xcd_barrier(xbar); FRESH(); } while (0)
    GEMM_UP((const bf16_t*)(ws + WS_XB), WS_W1U);
    GSYNC();
    GEMM_DOWN((const bf16_t*)(ws + WS_HID), WS_W1D, FF, (const bf16_t*)nullptr, 0.5f, WS_PRE1);
    GSYNC();
    if (HAS(3)) ln_phase((const bf16_t*)(ws + WS_PRE1), args.in[6], args.in[7], (bf16_t*)(ws + WS_H1), nullptr, G);
    GSYNC();
    if (HAS(4)) { pg8::Gemm g{(const bf16_t*)(ws + WS_H1), (const bf16_t*)(ws + WS_WIN), MT, NWIN, 1024}; pg8::StaticOrder S; S.init(MT, NWIN, G, (int)blockIdx.x);
        pg8::EpiWin E{ws, out}; pg8::gemm_phase<pg8::EpiWin, pg8::StaticOrder, true, true>(lds, g, S, E); }
    GSYNC();
    if (HAS(5)) for (int u = blockIdx.x; u < 544; u += G) gate_unit(ap, lds, u);
    if (HAS(6)) {
        if (G == 256) {
            const int k = blockIdx.x;
            if (k < 64) sel_unit(ap, lds, k);
            for (int i = 0; i < 32; ++i) { const int r = i & 3, p = (r & 1) ? (256 * (r + 1) - 1 - k) : (256 * r + k); sel_unit(ap, lds, 64 + (i >> 2) * 1024 + p); }
        } else for (int u = blockIdx.x; u < 64 + 8192; u += G) sel_unit(ap, lds, u);
    }
    GSYNC();
    if (HAS(6)) { { LAS float* REL = (LAS float*)(lds + LDS_AUX + 4096); if (tid < 512) REL[tid] = args.in[5][tid]; }
        __syncthreads();
        if ((G & 7) == 0) { const int bid = blockIdx.x, kvh = bid & 3, par = (bid >> 2) & 1, rank = bid >> 3, nrank = G >> 3;
            for (int qb = 2 * rank + par; qb < MT / 8; qb += 2 * nrank) att_unit(ap, lds, qb, kvh); }
        else for (int u = blockIdx.x; u < (MT / 8) * 4; u += G) att_unit(ap, lds, u >> 2, u & 3); }
    GSYNC();
    GEMM_BR((const bf16_t*)(ws + WS_Q), WS_WA, (const bf16_t*)out, 0);
    FRESH();
    GEMM_BR((const bf16_t*)(ws + WS_U), WS_WB, (const bf16_t*)out + (size_t)MT * 1024, 1);
    GSYNC();
    GEMM_DOWN((const bf16_t*)(ws + WS_VPRE), WS_WO, 1024, (const bf16_t*)(ws + WS_H1), 1.0f, WS_PRE2);
    GSYNC();
    if (HAS(3)) ln_phase((const bf16_t*)(ws + WS_PRE2), args.in[19], args.in[20], (bf16_t*)(ws + WS_XB), nullptr, G);
    GSYNC();
    GEMM_UP((const bf16_t*)(ws + WS_XB), WS_W2U);
    GSYNC();
    GEMM_DOWN((const bf16_t*)(ws + WS_HID), WS_W2D, FF, (const bf16_t*)(ws + WS_XB), 0.5f, WS_PRE3);
    GSYNC();
    if (HAS(3)) ln_phase((const bf16_t*)(ws + WS_PRE3), args.in[24], args.in[25], nullptr, out, G);
#undef args
}

extern "C" void kernel_launch(void* const* d_in, const int* in_sizes, int n_in, void* d_out, int out_size, void* d_ws, size_t ws_size, hipStream_t stream) {
    static int grid = 0;
    if (grid == 0) {
        if (n_in != 26 || ws_size < WS_END || (size_t)out_size != O_END || ws_size < 1024 * MiB) { fprintf(stderr, "kernel_launch: unexpected shapes n_in %d out %d ws %zu\n", n_in, out_size, ws_size); grid = -1; return; }
        int dev = 0, cus = 0, per_cu = 0;
        hipGetDevice(&dev); hipDeviceGetAttribute(&cus, hipDeviceAttributeMultiprocessorCount, dev);
        if (hipFuncSetAttribute((const void*)fwd_megakernel, hipFuncAttributeMaxDynamicSharedMemorySize, LDS_BYTES) != hipSuccess) { fprintf(stderr, "kernel_launch: hipFuncSetAttribute failed\n"); grid = -1; return; }
        if (hipOccupancyMaxActiveBlocksPerMultiprocessor(&per_cu, (const void*)fwd_megakernel, NTHREADS, LDS_BYTES) != hipSuccess || per_cu < 1) { fprintf(stderr, "kernel_launch: occupancy query says %d\n", per_cu); per_cu = 1; }
        (void)hipGetLastError();
        grid = cus * per_cu;
    }
    if (grid < 0) return;
    Args a{};
    for (int i = 0; i < 26; ++i) a.in[i] = (const float*)d_in[i];
    a.out = (float*)d_out; a.ws = (unsigned char*)d_ws;
    void* kargs[] = {&a};
    hipError_t e = hipLaunchCooperativeKernel((const void*)fwd_megakernel, dim3(grid), dim3(NTHREADS), kargs, LDS_BYTES, stream);
    if (e != hipSuccess) fprintf(stderr, "cooperative launch failed: %s (grid %d)\n", hipGetErrorString(e), grid);
}
```

```cpp
#include <hip/hip_runtime.h>
#include <hip/hip_cooperative_groups.h>
#include <cstdio>
#include <cstdint>
namespace cg = cooperative_groups;

constexpr int MP = 65536, MS = 512, MT = MP + MS, DM = 1024, FF = 2816, NUP = 2 * FF, NWIN = 6400, WIN_SRC = 6216;
constexpr int SEQ = 8192, LTOT = 1040;
constexpr float LN_EPS = 1e-5f;
constexpr int NWAVES = 8, NTHREADS = 512;
constexpr int LDS_BYTES = 163840;
constexpr size_t O_YP = 0, O_YS = (size_t)MP * 1024, O_KP = O_YS + (size_t)MS * 1024, O_VP = O_KP + (size_t)MP * 256, O_KIP = O_VP + (size_t)MP * 256,
                 O_KS = O_KIP + (size_t)MP * 64, O_VS = O_KS + (size_t)MS * 256, O_KIS = O_VS + (size_t)MS * 256, O_GV = O_KIS + (size_t)MS * 64, O_END = O_GV + (size_t)MS * 1024;
constexpr size_t MiB = 1u << 20;
constexpr size_t WS_BAR = 64 * 1024;
constexpr size_t WS_W1U = 1 * MiB, WS_W1D = 12 * MiB, WS_W2U = 18 * MiB, WS_W2D = 29 * MiB, WS_WIN = 35 * MiB, WS_WA = 48 * MiB, WS_WB = 50 * MiB, WS_WO = 52 * MiB, WS_WGM = 54 * MiB;
constexpr size_t WS_KS = 55 * MiB, WS_VS = 72 * MiB, WS_KIS = 89 * MiB;
constexpr size_t WS_XB = 104 * MiB, WS_H1 = 233 * MiB, WS_HID = 362 * MiB;
constexpr size_t WS_Q = 362 * MiB, WS_U = 491 * MiB, WS_VPRE = 620 * MiB, WS_QI = 749 * MiB, WS_KP = 814 * MiB, WS_VP = 846 * MiB, WS_KIP = 878 * MiB, WS_WI = 886 * MiB, WS_SEL = 890 * MiB, WS_END = 956 * MiB;
constexpr size_t WS_PRE1 = WS_SEL, WS_PRE2 = WS_Q, WS_PRE3 = WS_H1;
static_assert(WS_SEL + (size_t)MT * 1024 * 2 <= 1024 * MiB, "pre1 fits the workspace");
static_assert((size_t)MT * 1024 * 2 <= 129 * MiB && (size_t)MT * FF * 2 <= 355 * MiB && (size_t)MT * 512 * 2 <= 65 * MiB, "ws map");


namespace pg8 {
#define PG8_LAS __attribute__((address_space(3)))
typedef unsigned short bf16_t;
typedef short bf16x8 __attribute__((ext_vector_type(8)));
typedef float f32x4 __attribute__((ext_vector_type(4)));
typedef unsigned u32x4 __attribute__((ext_vector_type(4)));
constexpr int BM = 256, BK = 64, HALF = 128, HTB = HALF * BK * 2  , STAGE_BYTES = 8 * HTB, NXCD = 8, WGM = 8;

__host__ __device__ __forceinline__ int lds_byte(int r, int c) { const int st = (r >> 4) * 2 + (c >> 5), rr = r & 15, cc = c & 31, ob = rr * 64 + cc * 2; return st * 1024 + (ob ^ (((ob >> 9) & 1) << 5)); }
__host__ __device__ __forceinline__ void stage_rc(int b, int& R, int& C) { const int st = b / 1024, sb = b % 1024, swz = sb ^ (((sb >> 9) & 1) << 5); R = (st >> 1) * 16 + swz / 64; C = (st & 1) * 32 + (swz % 64) / 2; }
__host__ __device__ __forceinline__ int perm32(int rho) { const int n = rho >> 4, i = rho & 15; return 8 * (i >> 2) + 4 * n + (i & 3); }

struct Unit { int pm, pn; };
struct Gemm { const bf16_t* A; const bf16_t* Bt; int M, N, K; };

struct StaticOrder {
    int nM, nN, nwg, G, c;
    __host__ __device__ void init(int M, int N, int G_, int c_) { nM = M / BM; nN = N / BM; nwg = nM * nN; G = G_; c = c_; }
    __host__ __device__ bool next(int i, Unit& u) const {
        const long L = (long)i * G + c; if (L >= nwg) return false;
        int wgid = (int)L; { const int q = nwg / NXCD, r = nwg % NXCD, xcd = wgid % NXCD, off = wgid / NXCD; wgid = (xcd < r ? xcd * (q + 1) : r * (q + 1) + (xcd - r) * q) + off; }
        const int nig = WGM * nN, gid = wgid / nig, fm = gid * WGM, gsz = (nM - fm) < WGM ? (nM - fm) : WGM;
        u.pm = fm + ((wgid % nig) % gsz); u.pn = (wgid % nig) / gsz; return true;
    }
    __device__ __forceinline__ void a_ready(const Unit&) const {}
    __device__ __forceinline__ void done(const Unit&) const {}
};

typedef float f32x2v __attribute__((ext_vector_type(2)));
typedef __bf16 bf16x2v __attribute__((ext_vector_type(2)));
__device__ __forceinline__ unsigned pkbf(float lo, float hi) { f32x2v v = {lo, hi}; bf16x2v b = __builtin_convertvector(v, bf16x2v); return __builtin_bit_cast(unsigned, b); }
__device__ __forceinline__ float bflo(unsigned w) { return __uint_as_float(w << 16); }
__device__ __forceinline__ float bfhi(unsigned w) { return __uint_as_float(w & 0xffff0000u); }
__device__ __forceinline__ float fsigmoid(float x) { return __builtin_amdgcn_rcpf(1.0f + __expf(-x)); }
__device__ __forceinline__ float fgelu(float x) { const float t = 1.5957691216057308f * (x + 0.044715f * x * x * x); return x * fsigmoid(t); }
constexpr int E_MP = MP;
constexpr float E_ALPHA = 1.189207115002721f;

struct EpiUp {
    static constexpr bool PERM = true, AFTER_DRAIN = false;
    bf16_t* O;
    __device__ __forceinline__ void operator()(const f32x4 (&acc)[2][2][4][2], const Unit& u, int wr, int wc, int fr, int fq) const {
        const int row0 = u.pm * BM + wr * 64 + fr, col0 = u.pn * 128 + wc * 32 + 8 * fq;
#pragma unroll
        for (int ai = 0; ai < 2; ++ai)
#pragma unroll
            for (int m = 0; m < 4; ++m) {
                float h[8];
#pragma unroll
                for (int n = 0; n < 2; ++n)
#pragma unroll
                    for (int e = 0; e < 4; ++e) { const float g = acc[ai][0][m][n][e], up = acc[ai][1][m][n][e]; h[4 * n + e] = g * fsigmoid(g) * up; }
                u32x4 w; w.x = pkbf(h[0], h[1]); w.y = pkbf(h[2], h[3]); w.z = pkbf(h[4], h[5]); w.w = pkbf(h[6], h[7]);
                *(u32x4*)(O + (size_t)(row0 + ai * HALF + m * 16) * 2816 + col0) = w;
            }
    }
};
struct EpiDown {
    static constexpr bool PERM = true, AFTER_DRAIN = false;
    bf16_t* out; const float* xp; const float* xs; const bf16_t* resb; float scale;
    __device__ __forceinline__ void operator()(const f32x4 (&acc)[2][2][4][2], const Unit& u, int wr, int wc, int fr, int fq) const {
        const int row0 = u.pm * BM + wr * 64 + fr, col0 = u.pn * BM + wc * 32 + 8 * fq;
#pragma unroll
        for (int ai = 0; ai < 2; ++ai) {
            if (resb) {
                u32x4 rw[4][2];
#pragma unroll
                for (int m = 0; m < 4; ++m)
#pragma unroll
                    for (int bj = 0; bj < 2; ++bj) rw[m][bj] = *(const u32x4*)(resb + (size_t)(row0 + ai * HALF + m * 16) * 1024 + col0 + bj * HALF);
#pragma unroll
                for (int m = 0; m < 4; ++m)
#pragma unroll
                    for (int bj = 0; bj < 2; ++bj) { const u32x4 w0 = rw[m][bj];
                        const f32x4 r0 = (f32x4){bflo(w0.x), bfhi(w0.x), bflo(w0.y), bfhi(w0.y)}, r1 = (f32x4){bflo(w0.z), bfhi(w0.z), bflo(w0.w), bfhi(w0.w)};
                        const f32x4 o0 = r0 * E_ALPHA + acc[ai][bj][m][0] * scale, o1 = r1 * E_ALPHA + acc[ai][bj][m][1] * scale;
                        u32x4 w; w.x = pkbf(o0[0], o0[1]); w.y = pkbf(o0[2], o0[3]); w.z = pkbf(o1[0], o1[1]); w.w = pkbf(o1[2], o1[3]);
                        *(u32x4*)(out + (size_t)(row0 + ai * HALF + m * 16) * 1024 + col0 + bj * HALF) = w; }
                asm volatile("" ::: "memory");
            } else {
#pragma unroll
                for (int m = 0; m < 4; m += 2) {
                    f32x4 rf[2][2][2];
#pragma unroll
                    for (int mm = 0; mm < 2; ++mm) { const int row = row0 + ai * HALF + (m + mm) * 16;
                        const float* rp = (row < E_MP ? xp + (size_t)row * 1024 : xs + (size_t)(row - E_MP) * 1024) + col0;
#pragma unroll
                        for (int bj = 0; bj < 2; ++bj) { rf[mm][bj][0] = *(const f32x4*)(rp + bj * HALF); rf[mm][bj][1] = *(const f32x4*)(rp + bj * HALF + 4); } }
#pragma unroll
                    for (int mm = 0; mm < 2; ++mm)
#pragma unroll
                        for (int bj = 0; bj < 2; ++bj) { const f32x4 o0 = rf[mm][bj][0] * E_ALPHA + acc[ai][bj][m + mm][0] * scale, o1 = rf[mm][bj][1] * E_ALPHA + acc[ai][bj][m + mm][1] * scale;
                            u32x4 w; w.x = pkbf(o0[0], o0[1]); w.y = pkbf(o0[2], o0[3]); w.z = pkbf(o1[0], o1[1]); w.w = pkbf(o1[2], o1[3]);
                            *(u32x4*)(out + (size_t)(row0 + ai * HALF + (m + mm) * 16) * 1024 + col0 + bj * HALF) = w; }
                    asm volatile("" ::: "memory");
                }
            }
        }
    }
};
struct EpiBr {
    static constexpr bool PERM = true, AFTER_DRAIN = false;
    bf16_t* mb; const bf16_t* gate; int mode;
    __device__ __forceinline__ void operator()(const f32x4 (&acc)[2][2][4][2], const Unit& u, int wr, int wc, int fr, int fq) const {
        const int row0 = u.pm * BM + wr * 64 + fr, col0 = u.pn * BM + wc * 32 + 8 * fq;
#pragma unroll
        for (int ai = 0; ai < 2; ++ai) {
            u32x4 gw[4][2], pw[4][2];
#pragma unroll
            for (int m = 0; m < 4; ++m)
#pragma unroll
                for (int bj = 0; bj < 2; ++bj) { const size_t off = (size_t)(row0 + ai * HALF + m * 16) * 1024 + col0 + bj * HALF;
                    gw[m][bj] = *(const u32x4*)(gate + off); pw[m][bj] = (u32x4){0u, 0u, 0u, 0u}; if (mode) pw[m][bj] = *(const u32x4*)(mb + off); }
#pragma unroll
            for (int m = 0; m < 4; ++m)
#pragma unroll
                for (int bj = 0; bj < 2; ++bj) { const size_t off = (size_t)(row0 + ai * HALF + m * 16) * 1024 + col0 + bj * HALF;
                    const u32x4 g = gw[m][bj], p = pw[m][bj];
                    float v[8];
                    v[0] = bflo(g.x) * acc[ai][bj][m][0][0] + bflo(p.x); v[1] = bfhi(g.x) * acc[ai][bj][m][0][1] + bfhi(p.x); v[2] = bflo(g.y) * acc[ai][bj][m][0][2] + bflo(p.y); v[3] = bfhi(g.y) * acc[ai][bj][m][0][3] + bfhi(p.y);
                    v[4] = bflo(g.z) * acc[ai][bj][m][1][0] + bflo(p.z); v[5] = bfhi(g.z) * acc[ai][bj][m][1][1] + bfhi(p.z); v[6] = bflo(g.w) * acc[ai][bj][m][1][2] + bflo(p.w); v[7] = bfhi(g.w) * acc[ai][bj][m][1][3] + bfhi(p.w);
                    u32x4 w; w.x = pkbf(v[0], v[1]); w.y = pkbf(v[2], v[3]); w.z = pkbf(v[4], v[5]); w.w = pkbf(v[6], v[7]);
                    *(u32x4*)(mb + off) = w; }
            asm volatile("" ::: "memory");
        }
    }
};
struct EpiWin {
    static constexpr bool PERM = true, AFTER_DRAIN = false;
    unsigned char* ws; float* out;
    __device__ __forceinline__ void operator()(const f32x4 (&acc)[2][2][4][2], const Unit& u, int wr, int wc, int fr, int fq) const {
        const int row0 = u.pm * BM + wr * 64 + fr, cw = wc * 32 + 8 * fq, pn = u.pn;
        int act = 0, pitch = 1024, ctile = 0; size_t bbase = 0; bool b_in_out = false;
        if (pn < 4) { bbase = WS_Q; ctile = pn * 256; }
        else if (pn < 6) { pitch = 256; }
        else if (pn < 8) { bbase = WS_QI; pitch = 512; ctile = (pn - 6) * 256; }
        else if (pn == 8) { pitch = 64; }
        else if (pn < 13) { bbase = WS_U; ctile = (pn - 9) * 256; act = 1; }
        else if (pn < 17) { bbase = WS_VPRE; ctile = (pn - 13) * 256; act = 1; }
        else if (pn < 21) { bbase = 0; b_in_out = true; ctile = (pn - 17) * 256; act = 2; }
        else { bbase = (size_t)MT * 1024 * 2; b_in_out = true; ctile = (pn - 21) * 256; act = 2; }
#pragma unroll
        for (int ai = 0; ai < 2; ++ai)
#pragma unroll
            for (int m = 0; m < 4; ++m) {
                const int row = row0 + ai * HALF + m * 16;
                const bool samp = row >= E_MP; const int rs = row - E_MP; const int srow = (rs >> 4) * 1040 + 1024 + (rs & 15);
#pragma unroll
                for (int bj = 0; bj < 2; ++bj) {
                    const int cc = cw + bj * HALF;
                    float v[8];
#pragma unroll
                    for (int e = 0; e < 4; ++e) { v[e] = acc[ai][bj][m][0][e]; v[4 + e] = acc[ai][bj][m][1][e]; }
                    if (act == 1) {
#pragma unroll
                        for (int e = 0; e < 8; ++e) v[e] = fgelu(v[e]); }
                    else if (act == 2) {
#pragma unroll
                        for (int e = 0; e < 8; ++e) v[e] = fsigmoid(v[e]); }
                    bf16_t* dst = nullptr; float* fo = nullptr;
                    if (pn == 4 || pn == 5) {
                        const size_t bo = samp ? (pn == 4 ? WS_KS : WS_VS) + ((size_t)srow * 256 + cc) * 2 : (pn == 4 ? WS_KP : WS_VP) + ((size_t)row * 256 + cc) * 2;
                        dst = (bf16_t*)(ws + bo);
                        fo = out + (samp ? (pn == 4 ? O_KS : O_VS) + (size_t)rs * 256 + cc : (pn == 4 ? O_KP : O_VP) + (size_t)row * 256 + cc);
                    } else if (pn == 8) {
                        if (cc < 64) { dst = (bf16_t*)(ws + (samp ? WS_KIS + ((size_t)srow * 64 + cc) * 2 : WS_KIP + ((size_t)row * 64 + cc) * 2));
                                       fo = out + (samp ? O_KIS + (size_t)rs * 64 + cc : O_KIP + (size_t)row * 64 + cc); }
                        else if (cc == 64) fo = (float*)(ws + WS_WI) + (size_t)row * 8;
                    } else {
                        const size_t bo = bbase + ((size_t)row * pitch + ctile + cc) * 2;
                        dst = (bf16_t*)((b_in_out ? (unsigned char*)out : ws) + bo);
                    }
                    if (fo) { *(f32x4*)fo = (f32x4){v[0], v[1], v[2], v[3]}; *(f32x4*)(fo + 4) = (f32x4){v[4], v[5], v[6], v[7]}; }
                    if (dst) { u32x4 w; w.x = pkbf(v[0], v[1]); w.y = pkbf(v[2], v[3]); w.z = pkbf(v[4], v[5]); w.w = pkbf(v[6], v[7]); *(u32x4*)dst = w; }
                }
                asm volatile("" ::: "memory");
            }
    }
};

template <class Epi, class Sched, bool ALIGN_EPI = false, bool SP2 = false>
__device__ __forceinline__ void gemm_phase(PG8_LAS unsigned char* lds, const Gemm g, const Sched& S, const Epi& E) {
    int tid_ = threadIdx.x; asm volatile("" : "+v"(tid_)); const int tid = tid_, wid = __builtin_amdgcn_readfirstlane(tid >> 6), lane = tid & 63, wr = wid >> 2, wc = wid & 3, fr = lane & 15, fq = lane >> 4;
    const int K = g.K, nt = K / BK;
    unsigned voffA[2], voffB[2];
#pragma unroll
    for (int i = 0; i < 2; ++i) { int R, C; stage_rc(tid * 16 + i * 8192, R, C); const int Rb = Epi::PERM ? ((R & ~31) + perm32(R & 31)) : R;
        voffA[i] = (unsigned)(R * K + C) * 2u; voffB[i] = (unsigned)(Rb * K + C) * 2u; }
    const size_t kstep = (size_t)(BK * 2);
    const size_t hstep = (size_t)HALF * K * 2;
    const size_t tstep = 2 * hstep;
    const unsigned ldsw = (unsigned)wid * 1024u;
    const int aoff = lds_byte(wr * 64 + fr, fq * 8), boff = lds_byte(wc * 32 + fr, fq * 8);
#define PG8_SA(b, h) (((b) * 2 + (h)) * HTB)
#define PG8_SB(b, h) ((4 + (b) * 2 + (h)) * HTB)
#define PG8_STAGE(bufoff, gbase, voff) do { _Pragma("unroll") for (int _i = 0; _i < 2; ++_i) \
        __builtin_amdgcn_global_load_lds((const unsigned*)((const char*)(gbase) + (voff)[_i]), (PG8_LAS unsigned*)(lds + (bufoff) + ldsw + _i * 8192), 16, 0, 0); } while (0)
#define PG8_LDA(dst, b, h) do { _Pragma("unroll") for (int m = 0; m < 4; ++m) _Pragma("unroll") for (int k = 0; k < 2; ++k) dst[m][k] = *(const PG8_LAS bf16x8*)(lds + PG8_SA(b, h) + aoff + m * 2048 + k * 1024); } while (0)
#define PG8_LDB(dst, b, h) do { _Pragma("unroll") for (int n = 0; n < 2; ++n) _Pragma("unroll") for (int k = 0; k < 2; ++k) dst[n][k] = *(const PG8_LAS bf16x8*)(lds + PG8_SB(b, h) + boff + n * 2048 + k * 1024); } while (0)
#define PG8_MMA(ai, bj, At, Bt) do { __builtin_amdgcn_s_setprio(1); _Pragma("unroll") for (int m = 0; m < 4; ++m) _Pragma("unroll") for (int n = 0; n < 2; ++n) _Pragma("unroll") for (int k = 0; k < 2; ++k) \
        acc[ai][bj][m][n] = __builtin_amdgcn_mfma_f32_16x16x32_bf16(Bt[n][k], At[m][k], acc[ai][bj][m][n], 0, 0, 0); __builtin_amdgcn_s_setprio(0); } while (0)
#define PG8_WAIT_V(n) asm volatile("s_waitcnt vmcnt(" #n ")" ::: "memory")
#define PG8_WAIT_L(n) asm volatile("s_waitcnt lgkmcnt(" #n ")" ::: "memory")
#define PG8_BAR __builtin_amdgcn_s_barrier()
#define PG8_SCHED __builtin_amdgcn_sched_barrier(0)
    Unit cur, nxt; int ui = 0;
    if (!S.next(0, cur)) return;
    f32x4 acc[2][2][4][2];
#pragma unroll
    for (int a = 0; a < 2; ++a)
#pragma unroll
        for (int b = 0; b < 2; ++b)
#pragma unroll
            for (int m = 0; m < 4; ++m)
#pragma unroll
                for (int n = 0; n < 2; ++n) acc[a][b][m][n] = (f32x4){0.f, 0.f, 0.f, 0.f};
    bf16x8 At[4][2], B0[2][2], B1[2][2];
    const char* cA = (const char*)g.A + (size_t)cur.pm * tstep; const char* cB = (const char*)g.Bt + (size_t)cur.pn * tstep;
    S.a_ready(cur);
    if constexpr (SP2) {
        PG8_STAGE(PG8_SB(0, 0), cB, voffB); PG8_STAGE(PG8_SB(0, 1), cB + hstep, voffB); PG8_STAGE(PG8_SA(0, 0), cA, voffA); PG8_STAGE(PG8_SA(0, 1), cA + hstep, voffA);
        if (wr == 1) PG8_BAR;
        PG8_WAIT_V(2); PG8_BAR;
        PG8_STAGE(PG8_SB(1, 0), cB + kstep, voffB); PG8_STAGE(PG8_SA(1, 0), cA + kstep, voffA); PG8_STAGE(PG8_SB(1, 1), cB + hstep + kstep, voffB);
        PG8_WAIT_V(6); PG8_BAR;
    } else {
        PG8_STAGE(PG8_SB(0, 0), cB, voffB); PG8_STAGE(PG8_SA(0, 0), cA, voffA); PG8_STAGE(PG8_SB(0, 1), cB + hstep, voffB); PG8_STAGE(PG8_SA(0, 1), cA + hstep, voffA);
        if (wr == 1) PG8_BAR;
        PG8_WAIT_V(4); PG8_BAR;
        PG8_STAGE(PG8_SB(1, 0), cB + kstep, voffB); PG8_STAGE(PG8_SA(1, 0), cA + kstep, voffA); PG8_STAGE(PG8_SB(1, 1), cB + hstep + kstep, voffB);
        PG8_WAIT_V(6); PG8_BAR;
    }
    for (;;) {
        const bool has_next = S.next(ui + 1, nxt);
        const char* nA = has_next ? (const char*)g.A + (size_t)nxt.pm * tstep : cA; const char* nB = has_next ? (const char*)g.Bt + (size_t)nxt.pn * tstep : cB;
        for (int t = 0; t < nt; t += 2) {
            const bool last = (t == nt - 2);
            const char* a1 = cA + (size_t)(t + 1) * kstep;
            const char* a2 = last ? nA : cA + (size_t)(t + 2) * kstep; const char* b2 = last ? nB : cB + (size_t)(t + 2) * kstep;
            const char* a3 = a2 + kstep; const char* b3 = b2 + kstep;
            if (last && has_next) S.a_ready(nxt);
            if constexpr (SP2) {
            PG8_LDB(B0, 0, 0); PG8_LDB(B1, 0, 1); PG8_SCHED; PG8_LDA(At, 0, 0); PG8_STAGE(PG8_SA(1, 1), a1 + hstep, voffA);
            PG8_WAIT_V(8); PG8_WAIT_L(0); PG8_BAR; PG8_MMA(0, 0, At, B0); PG8_MMA(0, 1, At, B1); PG8_BAR; PG8_SCHED;
            PG8_LDA(At, 0, 1); PG8_STAGE(PG8_SB(0, 0), b2, voffB); PG8_STAGE(PG8_SB(0, 1), b2 + hstep, voffB); PG8_STAGE(PG8_SA(0, 0), a2, voffA);
            PG8_WAIT_V(8); PG8_WAIT_L(0); PG8_BAR; PG8_MMA(1, 0, At, B0); PG8_MMA(1, 1, At, B1); PG8_BAR; PG8_SCHED;
            PG8_LDB(B0, 1, 0); PG8_LDB(B1, 1, 1); PG8_SCHED; PG8_LDA(At, 1, 0); PG8_STAGE(PG8_SA(0, 1), a2 + hstep, voffA);
            PG8_WAIT_V(8); PG8_WAIT_L(0); PG8_BAR; PG8_MMA(0, 0, At, B0); PG8_MMA(0, 1, At, B1); PG8_BAR; PG8_SCHED;
            PG8_LDA(At, 1, 1); PG8_STAGE(PG8_SB(1, 0), b3, voffB); PG8_STAGE(PG8_SB(1, 1), b3 + hstep, voffB); PG8_STAGE(PG8_SA(1, 0), a3, voffA);
            PG8_WAIT_V(8); PG8_WAIT_L(0); PG8_BAR; PG8_MMA(1, 0, At, B0); PG8_MMA(1, 1, At, B1); PG8_BAR; PG8_SCHED;
            } else {
            PG8_LDB(B0, 0, 0); PG8_SCHED; PG8_LDA(At, 0, 0); PG8_STAGE(PG8_SA(1, 1), a1 + hstep, voffA);
            PG8_WAIT_L(8); PG8_BAR; PG8_WAIT_L(0); PG8_MMA(0, 0, At, B0); PG8_BAR; PG8_SCHED;
            PG8_LDB(B1, 0, 1); PG8_STAGE(PG8_SB(0, 0), b2, voffB);
            PG8_BAR; PG8_WAIT_L(0); PG8_MMA(0, 1, At, B1); PG8_BAR;
            PG8_LDA(At, 0, 1); PG8_STAGE(PG8_SA(0, 0), a2, voffA);
            PG8_BAR; PG8_WAIT_L(0); PG8_MMA(1, 0, At, B0); PG8_BAR; PG8_SCHED;
            PG8_STAGE(PG8_SB(0, 1), b2 + hstep, voffB);
            PG8_WAIT_V(6); PG8_BAR; PG8_MMA(1, 1, At, B1); PG8_BAR;
            PG8_LDB(B0, 1, 0); PG8_SCHED; PG8_LDA(At, 1, 0); PG8_STAGE(PG8_SA(0, 1), a2 + hstep, voffA);
            PG8_WAIT_L(8); PG8_BAR; PG8_WAIT_L(0); PG8_MMA(0, 0, At, B0); PG8_BAR; PG8_SCHED;
            PG8_LDB(B1, 1, 1); PG8_STAGE(PG8_SB(1, 0), b3, voffB);
            PG8_BAR; PG8_WAIT_L(0); PG8_MMA(0, 1, At, B1); PG8_BAR;
            PG8_LDA(At, 1, 1); PG8_STAGE(PG8_SA(1, 0), a3, voffA);
            PG8_BAR; PG8_WAIT_L(0); PG8_MMA(1, 0, At, B0); PG8_BAR; PG8_SCHED;
            PG8_STAGE(PG8_SB(1, 1), b3 + hstep, voffB);
            PG8_WAIT_V(6); PG8_BAR; PG8_MMA(1, 1, At, B1); PG8_BAR;
            }
        }
        if constexpr (ALIGN_EPI) { if (wr == 0) PG8_BAR; }
        if constexpr (!Epi::AFTER_DRAIN) { E(acc, cur, wr, wc, fr, fq); S.done(cur); }
        if (!has_next) break;
#pragma unroll
        for (int a = 0; a < 2; ++a)
#pragma unroll
            for (int b = 0; b < 2; ++b)
#pragma unroll
                for (int m = 0; m < 4; ++m)
#pragma unroll
                    for (int n = 0; n < 2; ++n) acc[a][b][m][n] = (f32x4){0.f, 0.f, 0.f, 0.f};
        cur = nxt; cA = nA; cB = nB; ++ui;
        if constexpr (ALIGN_EPI) { if (wr == 1) PG8_BAR; }
    }
    PG8_WAIT_V(0);
    if constexpr (!ALIGN_EPI) { if (wr == 0) PG8_BAR; }
    PG8_BAR;
    if constexpr (Epi::AFTER_DRAIN) { E.fused(acc, cur, wr, wc, fr, fq, lds, wid, lane); S.done(cur); }
#undef PG8_SA
#undef PG8_SB
#undef PG8_STAGE
#undef PG8_LDA
#undef PG8_LDB
#undef PG8_MMA
#undef PG8_WAIT_V
#undef PG8_WAIT_L
#undef PG8_BAR
#undef PG8_SCHED
}
}

#define LAS __attribute__((address_space(3)))
typedef unsigned short bf16_t;
typedef short bf16x8 __attribute__((ext_vector_type(8)));
typedef short s16x4 __attribute__((ext_vector_type(4)));
typedef float f32x4 __attribute__((ext_vector_type(4)));
typedef float f32x16 __attribute__((ext_vector_type(16)));
typedef unsigned u32x4 __attribute__((ext_vector_type(4)));
typedef unsigned u32x2 __attribute__((ext_vector_type(2)));
using pg8::pkbf; using pg8::bflo; using pg8::bfhi;

struct Args { const float* in[26]; float* out; unsigned char* ws; };
typedef const __attribute__((address_space(4))) Args* ArgsP;

__device__ __forceinline__ float wave_sum(float v) {
#pragma unroll
    for (int o = 1; o < 64; o <<= 1) v += __shfl_xor(v, o);
    return v;
}
__device__ __forceinline__ int wave_sum_i(int v) {
    v += __builtin_amdgcn_update_dpp(0, v, 0x128, 0xf, 0xf, false);
    v += __builtin_amdgcn_update_dpp(0, v, 0x124, 0xf, 0xf, false);
    v += __builtin_amdgcn_update_dpp(0, v, 0x122, 0xf, 0xf, false);
    v += __builtin_amdgcn_update_dpp(0, v, 0x121, 0xf, 0xf, false);
    return __builtin_amdgcn_readlane(v, 0) + __builtin_amdgcn_readlane(v, 16) + __builtin_amdgcn_readlane(v, 32) + __builtin_amdgcn_readlane(v, 48);
}
__device__ __forceinline__ unsigned wave_or_u(unsigned v) {
    v |= (unsigned)__builtin_amdgcn_update_dpp(0, (int)v, 0x128, 0xf, 0xf, false);
    v |= (unsigned)__builtin_amdgcn_update_dpp(0, (int)v, 0x124, 0xf, 0xf, false);
    v |= (unsigned)__builtin_amdgcn_update_dpp(0, (int)v, 0x122, 0xf, 0xf, false);
    v |= (unsigned)__builtin_amdgcn_update_dpp(0, (int)v, 0x121, 0xf, 0xf, false);
    return (unsigned)(__builtin_amdgcn_readlane((int)v, 0) | __builtin_amdgcn_readlane((int)v, 16) | __builtin_amdgcn_readlane((int)v, 32) | __builtin_amdgcn_readlane((int)v, 48));
}
__device__ __forceinline__ void lds_wait() { asm volatile("s_waitcnt lgkmcnt(0)" ::: "memory"); }

__device__ __forceinline__ int rowmap(int mode, int n) {
    if (mode == 1) return 256 * (n >> 7) + (n & 127);
    if (mode == 2) return 256 * (n >> 7) + 128 + (n & 127);
    if (mode == 3) return n < 2120 ? n : n + 184;
    return n;
}
__device__ __forceinline__ void transpose_item(const float* W, int K, int N, bf16_t* WT, int mode, LAS float* scr, int item, int lane) {
    const int nblk = (N + 31) >> 5, kb = item / nblk, nb = item % nblk, k0 = 64 * kb, n0 = 32 * nb;
    { const int ch = lane & 7, nn = n0 + 4 * ch;
      f32x4 v[8];
#pragma unroll
      for (int i = 0; i < 8; ++i) { v[i] = (f32x4){0.f, 0.f, 0.f, 0.f}; if (nn < N) v[i] = *(const f32x4*)(W + (size_t)(k0 + 8 * i + (lane >> 3)) * N + nn); }
#pragma unroll
      for (int i = 0; i < 8; ++i) { LAS float* d = scr + (8 * i + (lane >> 3)) * 33 + 4 * ch; d[0] = v[i].x; d[1] = v[i].y; d[2] = v[i].z; d[3] = v[i].w; } }
    lds_wait();
    const int c = lane & 7;
#pragma unroll
    for (int j = 0; j < 4; ++j) { const int n = (lane >> 3) + 8 * j; const LAS float* s = scr + (8 * c) * 33 + n;
        u32x4 o; o.x = pkbf(s[0 * 33], s[1 * 33]); o.y = pkbf(s[2 * 33], s[3 * 33]); o.z = pkbf(s[4 * 33], s[5 * 33]); o.w = pkbf(s[6 * 33], s[7 * 33]);
        if (n0 + n < N) *(u32x4*)(WT + (size_t)rowmap(mode, n0 + n) * K + k0 + 8 * c) = o; }
    lds_wait();
}
__device__ __forceinline__ void cvt_row4(const float* src, bf16_t* dst) { const f32x4 v = *(const f32x4*)src; u32x2 w; w.x = pkbf(v.x, v.y); w.y = pkbf(v.z, v.w); *(u32x2*)dst = w; }

__device__ __forceinline__ void prologue(ArgsP a, LAS unsigned char* lds, int G) {
    int tid_ = threadIdx.x; asm volatile("" : "+v"(tid_)); const int tid = tid_, lane = tid & 63, wave = tid >> 6;
    const int gw = blockIdx.x * NWAVES + wave, NGW = G * NWAVES;
    LAS float* scr = (LAS float*)(lds + wave * 16384);
    unsigned char* ws = a->ws;
    constexpr int I_UP = 16 * 88, I_DN = 44 * 32, I_IN = 16 * 195, I_SQ = 16 * 32;
    constexpr int NITEMS = 4 * I_UP + 2 * I_DN + I_IN + 3 * I_SQ;
    for (int it = gw; it < NITEMS; it += NGW) {
        int r = it;
        if (r < I_UP) { transpose_item(a->in[8], 1024, FF, (bf16_t*)(ws + WS_W1U), 1, scr, r, lane); continue; } r -= I_UP;
        if (r < I_UP) { transpose_item(a->in[9], 1024, FF, (bf16_t*)(ws + WS_W1U), 2, scr, r, lane); continue; } r -= I_UP;
        if (r < I_UP) { transpose_item(a->in[21], 1024, FF, (bf16_t*)(ws + WS_W2U), 1, scr, r, lane); continue; } r -= I_UP;
        if (r < I_UP) { transpose_item(a->in[22], 1024, FF, (bf16_t*)(ws + WS_W2U), 2, scr, r, lane); continue; } r -= I_UP;
        if (r < I_DN) { transpose_item(a->in[10], FF, 1024, (bf16_t*)(ws + WS_W1D), 0, scr, r, lane); continue; } r -= I_DN;
        if (r < I_DN) { transpose_item(a->in[23], FF, 1024, (bf16_t*)(ws + WS_W2D), 0, scr, r, lane); continue; } r -= I_DN;
        if (r < I_IN) { transpose_item(a->in[11], 1024, WIN_SRC, (bf16_t*)(ws + WS_WIN), 3, scr, r, lane); continue; } r -= I_IN;
        if (r < I_SQ) { transpose_item(a->in[16], 1024, 1024, (bf16_t*)(ws + WS_WA), 0, scr, r, lane); continue; } r -= I_SQ;
        if (r < I_SQ) { transpose_item(a->in[17], 1024, 1024, (bf16_t*)(ws + WS_WB), 0, scr, r, lane); continue; } r -= I_SQ;
        transpose_item(a->in[18], 1024, 1024, (bf16_t*)(ws + WS_WO), 0, scr, r, lane);
    }
    bf16_t* xb = (bf16_t*)(ws + WS_XB);
    for (int m = gw; m < MT; m += NGW) {
        const float* src = m < MP ? a->in[0] + (size_t)m * 1024 : a->in[1] + (size_t)(m - MP) * 1024;
#pragma unroll
        for (int j = 0; j < 4; ++j) cvt_row4(src + 4 * lane + 256 * j, xb + (size_t)m * 1024 + 4 * lane + 256 * j);
    }
    bf16_t *ks = (bf16_t*)(ws + WS_KS), *vs = (bf16_t*)(ws + WS_VS), *kis = (bf16_t*)(ws + WS_KIS);
    for (int r = gw; r < 32 * 1024; r += NGW) { const int b = r >> 10, s = r & 1023; const size_t d = ((size_t)b * LTOT + s) * 256 + 4 * lane;
        cvt_row4(a->in[2] + (size_t)r * 256 + 4 * lane, ks + d); cvt_row4(a->in[3] + (size_t)r * 256 + 4 * lane, vs + d); }
    for (int r4 = gw; r4 < 32 * 1024 / 4; r4 += NGW) { const int r = 4 * r4 + (lane >> 4), b = r >> 10, s = r & 1023, c = 4 * (lane & 15);
        cvt_row4(a->in[4] + (size_t)r * 64 + c, kis + ((size_t)b * LTOT + s) * 64 + c); }
    const int gt = blockIdx.x * NTHREADS + tid, NGT = G * NTHREADS;
    bf16_t* wgm = (bf16_t*)(ws + WS_WGM);
    for (int idx = gt; idx < 4 * 128 * 128; idx += NGT) { const int i = (idx >> 7) & 127, j = idx & 127; const float v = j <= i ? a->in[14][idx] : 0.f; wgm[idx] = (bf16_t)(pkbf(v, 0.f) & 0xffffu); }
    u32x4* wz = (u32x4*)((bf16_t*)(ws + WS_WIN) + (size_t)2120 * 1024);
    for (int idx = gt; idx < 184 * 128; idx += NGT) wz[idx] = (u32x4){0u, 0u, 0u, 0u};
}

__device__ __forceinline__ void ln_phase(const bf16_t* in, const float* g, const float* b, bf16_t* ob, float* of, int G) {
    int tid_ = threadIdx.x; asm volatile("" : "+v"(tid_)); const int tid = tid_, lane = tid & 63, wave = tid >> 6;
    const int gw = blockIdx.x * NWAVES + wave, NGW = G * NWAVES;
    f32x4 gv[4], bv[4];
#pragma unroll
    for (int j = 0; j < 4; ++j) { gv[j] = *(const f32x4*)(g + 4 * lane + 256 * j); bv[j] = *(const f32x4*)(b + 4 * lane + 256 * j); }
    for (int m = gw; m < MT; m += NGW) {
        const bf16_t* xr = in + (size_t)m * 1024 + 4 * lane;
        f32x4 v[4]; float s = 0.f;
#pragma unroll
        for (int j = 0; j < 4; ++j) { const u32x2 w = *(const u32x2*)(xr + 256 * j); v[j] = (f32x4){bflo(w.x), bfhi(w.x), bflo(w.y), bfhi(w.y)}; s += (v[j].x + v[j].y) + (v[j].z + v[j].w); }
        const float mean = wave_sum(s) * (1.f / 1024.f); float s2 = 0.f;
#pragma unroll
        for (int j = 0; j < 4; ++j) { v[j] = v[j] - mean; s2 += (v[j].x * v[j].x + v[j].y * v[j].y) + (v[j].z * v[j].z + v[j].w * v[j].w); }
        const float rstd = 1.f / sqrtf(wave_sum(s2) * (1.f / 1024.f) + LN_EPS);
#pragma unroll
        for (int j = 0; j < 4; ++j) { const f32x4 o = v[j] * rstd * gv[j] + bv[j];
            if (ob) { u32x2 w; w.x = pkbf(o.x, o.y); w.y = pkbf(o.z, o.w); *(u32x2*)(ob + (size_t)m * 1024 + 4 * lane + 256 * j) = w; }
            if (of) *(f32x4*)(of + (size_t)m * 1024 + 4 * lane + 256 * j) = o; }
    }
}

typedef short v4i16_t __attribute__((ext_vector_type(4)));
__device__ __forceinline__ s16x4 tr_read(const LAS unsigned char* p) { return __builtin_bit_cast(s16x4, __builtin_amdgcn_ds_read_tr16_b64_v4i16((LAS v4i16_t*)p)); }
constexpr int GIMG_STRIDE = 544;
constexpr int LDS_AUX = 131072;

__device__ __forceinline__ void gate_unit(ArgsP a, LAS unsigned char* lds, int unit) {
    int tid_ = threadIdx.x; asm volatile("" : "+v"(tid_)); const int tid = tid_, lane = tid & 63, wave = __builtin_amdgcn_readfirstlane(tid >> 6);
    const bool samp = unit >= 512;
    const int m0 = samp ? MP + 16 * (unit - 512) : 128 * unit, nrows = samp ? 16 : 128;
    const bf16_t* vpre = (const bf16_t*)(a->ws + WS_VPRE); bf16_t* ub = (bf16_t*)(a->ws + WS_U); const bf16_t* wgm = (const bf16_t*)(a->ws + WS_WGM);
    const float *gmg = a->in[12], *gmb = a->in[13], *gbs = a->in[15];
    LAS float* ST = (LAS float*)(lds + LDS_AUX);
    for (int rr = 0; rr < 16; ++rr) { const int row = wave * 16 + rr;
        if (row < nrows) { const bf16_t* rp = vpre + (size_t)(m0 + row) * 1024 + 8 * lane;
            const u32x4 w0 = *(const u32x4*)rp, w1 = *(const u32x4*)(rp + 512);
            float x[16] = {bflo(w0.x), bfhi(w0.x), bflo(w0.y), bfhi(w0.y), bflo(w0.z), bfhi(w0.z), bflo(w0.w), bfhi(w0.w), bflo(w1.x), bfhi(w1.x), bflo(w1.y), bfhi(w1.y), bflo(w1.z), bfhi(w1.z), bflo(w1.w), bfhi(w1.w)};
            float s = 0.f;
#pragma unroll
            for (int e = 0; e < 16; ++e) s += x[e];
            const float mean = wave_sum(s) * (1.f / 1024.f); float s2 = 0.f;
#pragma unroll
            for (int e = 0; e < 16; ++e) { const float d = x[e] - mean; s2 += d * d; }
            const float rstd = 1.f / sqrtf(wave_sum(s2) * (1.f / 1024.f) + LN_EPS);
            if (lane == 0) { ST[2 * row] = mean; ST[2 * row + 1] = rstd; } } }
    __syncthreads();
    const int j16 = lane & 15, kq = lane >> 4;
    for (int g = 0; g < 4; ++g) {
        { const int col = 8 * (tid & 31);
          const f32x4 g0 = *(const f32x4*)(gmg + 256 * g + col), g1 = *(const f32x4*)(gmg + 256 * g + col + 4), b0 = *(const f32x4*)(gmb + 256 * g + col), b1 = *(const f32x4*)(gmb + 256 * g + col + 4);
          u32x4 xr[8];
#pragma unroll
          for (int it = 0; it < 8; ++it) { const int row = it * 16 + (tid >> 5); xr[it] = (u32x4){0u, 0u, 0u, 0u}; if (row < nrows) xr[it] = *(const u32x4*)(vpre + (size_t)(m0 + row) * 1024 + 256 * g + col); }
#pragma unroll
          for (int it = 0; it < 8; ++it) { const int row = it * 16 + (tid >> 5); const float mean = ST[2 * row], rstd = ST[2 * row + 1]; u32x4 w = (u32x4){0u, 0u, 0u, 0u};
              if (row < nrows) { const u32x4 x = xr[it];
                  f32x4 y0 = (f32x4){bflo(x.x), bfhi(x.x), bflo(x.y), bfhi(x.y)}, y1 = (f32x4){bflo(x.z), bfhi(x.z), bflo(x.w), bfhi(x.w)};
                  y0 = (y0 - mean) * rstd * g0 + b0; y1 = (y1 - mean) * rstd * g1 + b1;
                  w.x = pkbf(y0.x, y0.y); w.y = pkbf(y0.z, y0.w); w.z = pkbf(y1.x, y1.y); w.w = pkbf(y1.z, y1.w);
                  if (samp) { float* o = a->out + O_GV + (size_t)(m0 - MP + row) * 1024 + 256 * g + col; *(f32x4*)o = y0; *(f32x4*)(o + 4) = y1; } }
              *(LAS u32x4*)(lds + row * GIMG_STRIDE + col * 2) = w; } }
        __syncthreads();
        const int ib = 32 * (wave & 3), cb = 128 * (wave >> 2);
        f32x4 acc[2][8];
#pragma unroll
        for (int it = 0; it < 2; ++it)
#pragma unroll
            for (int ct = 0; ct < 8; ++ct) acc[it][ct] = (f32x4){0.f, 0.f, 0.f, 0.f};
#pragma unroll
        for (int ks = 0; ks < 4; ++ks) if (ks <= (wave & 3)) {
            bf16x8 wf[2];
#pragma unroll
            for (int it = 0; it < 2; ++it) wf[it] = *(const bf16x8*)(wgm + (size_t)g * 16384 + (ib + 16 * it + j16) * 128 + 32 * ks + 8 * kq);
#pragma unroll
            for (int ct = 0; ct < 8; ++ct) {
                const LAS unsigned char* p = lds + (32 * ks + 8 * kq + (j16 >> 2)) * GIMG_STRIDE + (cb + 16 * ct + 4 * (j16 & 3)) * 2;
                const s16x4 lo = tr_read(p), hi = tr_read(p + 4 * GIMG_STRIDE);
                const bf16x8 vf = (bf16x8){lo[0], lo[1], lo[2], lo[3], hi[0], hi[1], hi[2], hi[3]};
#pragma unroll
                for (int it = 0; it < 2; ++it) acc[it][ct] = __builtin_amdgcn_mfma_f32_16x16x32_bf16(vf, wf[it], acc[it][ct], 0, 0, 0);
            }
        }
#pragma unroll
        for (int it = 0; it < 2; ++it) { const int i = ib + 16 * it + j16;
            if (i < nrows) { const float bsv = gbs[g * 128 + i];
#pragma unroll
                for (int ct = 0; ct < 8; ++ct) { bf16_t* up = ub + (size_t)(m0 + i) * 1024 + 256 * g + cb + 16 * ct + 4 * kq;
                    const u32x2 uu = *(const u32x2*)up; const f32x4 s = acc[it][ct] + bsv; u32x2 w;
                    w.x = pkbf(bflo(uu.x) * s.x, bfhi(uu.x) * s.y); w.y = pkbf(bflo(uu.y) * s.z, bfhi(uu.y) * s.w); *(u32x2*)up = w; } } }
        __syncthreads();
    }
}

constexpr int VST_STRIDE = 288, VST_BYTES = 32 * VST_STRIDE;
__device__ __forceinline__ unsigned f2key(float f) { const unsigned u = __float_as_uint(f); return u ^ ((unsigned)((int)u >> 31) | 0x80000000u); }
__device__ __forceinline__ unsigned sel_entry(int s, int qpos) {
    const int rel = s - qpos, n = rel < 0 ? -rel : rel;
    const int large = 8 + (n >= 12) + (n >= 16) + (n >= 23) + (n >= 32) + (n >= 46) + (n >= 64) + (n >= 91);
    const int bk = (rel > 0 ? 16 : 0) + (n < 8 ? n : large);
    return (unsigned)s | ((unsigned)bk << 16) | (1u << 24);
}

#define TRANSPOSE32(K0) do { \
    _Pragma("unroll") for (int k = 0; k < 16; ++k) { const unsigned x = key[(K0) + k], y = key[(K0) + k + 16]; \
        key[(K0) + k] = __builtin_amdgcn_perm(y, x, 0x05040100u); key[(K0) + k + 16] = __builtin_amdgcn_perm(y, x, 0x07060302u); } \
    _Pragma("unroll") for (int k = 0; k < 32; ++k) if ((k & 8) == 0) { const unsigned x = key[(K0) + k], y = key[(K0) + k + 8]; \
        key[(K0) + k] = __builtin_amdgcn_perm(y, x, 0x06020400u); key[(K0) + k + 8] = __builtin_amdgcn_perm(y, x, 0x07030501u); } \
    _Pragma("unroll") for (int k = 0; k < 32; ++k) if ((k & 4) == 0) { const unsigned x = key[(K0) + k], y = key[(K0) + k + 4]; \
        key[(K0) + k] = (x & 0x0f0f0f0fu) | ((y << 4) & 0xf0f0f0f0u); key[(K0) + k + 4] = ((x >> 4) & 0x0f0f0f0fu) | (y & 0xf0f0f0f0u); } \
    _Pragma("unroll") for (int k = 0; k < 32; ++k) if ((k & 2) == 0) { const unsigned x = key[(K0) + k], y = key[(K0) + k + 2]; \
        key[(K0) + k] = (x & 0x33333333u) | ((y << 2) & 0xccccccccu); key[(K0) + k + 2] = ((x >> 2) & 0x33333333u) | (y & 0xccccccccu); } \
    _Pragma("unroll") for (int k = 0; k < 32; ++k) if ((k & 1) == 0) { const unsigned x = key[(K0) + k], y = key[(K0) + k + 1]; \
        key[(K0) + k] = (x & 0x55555555u) | ((y << 1) & 0xaaaaaaaau); key[(K0) + k + 1] = ((x >> 1) & 0x55555555u) | (y & 0xaaaaaaaau); } } while (0)

__device__ __forceinline__ void sel_unit(ArgsP a, LAS unsigned char* lds, int unit) {
    int tid_ = threadIdx.x; asm volatile("" : "+v"(tid_)); const int tid = tid_, lane = tid & 63, wave = __builtin_amdgcn_readfirstlane(tid >> 6);
    int m0, nvis, qpos0; const bf16_t* Kib;
    if (unit < 64) { const int b = unit >> 1, i0 = (unit & 1) * 8; m0 = MP + b * 16 + i0; nvis = LTOT; qpos0 = 1024 + i0; Kib = (const bf16_t*)(a->ws + WS_KIS) + (size_t)b * LTOT * 64; }
    else { const int u = unit - 64, b = u >> 10, t0 = (u & 1023) * 8; m0 = b * SEQ + t0; nvis = ((t0 >> 6) + 1) * 64; qpos0 = t0; Kib = (const bf16_t*)(a->ws + WS_KIP) + (size_t)b * SEQ * 64; }
    const bf16_t* qib = (const bf16_t*)(a->ws + WS_QI); const float* wib = (const float*)(a->ws + WS_WI);
    LAS float* SC = (LAS float*)lds;
    LAS unsigned* SEL = (LAS unsigned*)(lds + LDS_AUX);
    LAS unsigned* sel = SEL + wave * 256; const LAS float* sc = SC + wave * 4096; const int qpos = qpos0 + wave;
    const int j = lane & 15, kq = lane >> 4;
    unsigned key[128];

    bf16x8 af[2][2][2];
    { const int tq = j >> 2;
#pragma unroll
      for (int qg = 0; qg < 2; ++qg)
#pragma unroll
        for (int mt = 0; mt < 2; ++mt) { const int hh = 4 * mt + (j & 3); const size_t mq = (size_t)(m0 + 4 * qg + tq); const float wabs = fabsf(wib[mq * 8 + hh]);
#pragma unroll
          for (int ks = 0; ks < 2; ++ks) { const u32x4 w = *(const u32x4*)(qib + mq * 512 + hh * 64 + 32 * ks + 8 * kq);
              u32x4 o; o.x = pkbf(bflo(w.x) * wabs, bfhi(w.x) * wabs); o.y = pkbf(bflo(w.y) * wabs, bfhi(w.y) * wabs); o.z = pkbf(bflo(w.z) * wabs, bfhi(w.z) * wabs); o.w = pkbf(bflo(w.w) * wabs, bfhi(w.w) * wabs);
              af[qg][mt][ks] = __builtin_bit_cast(bf16x8, o); } } }
    float sg[2][8];
#pragma unroll
    for (int qg = 0; qg < 2; ++qg)
#pragma unroll
        for (int r4 = 0; r4 < 2; ++r4) { const f32x4 w = *(const f32x4*)(wib + (size_t)(m0 + 4 * qg + kq) * 8 + 4 * r4);
#pragma unroll
            for (int e = 0; e < 4; ++e) sg[qg][4 * r4 + e] = w[e] > 0.f ? 1.f : (w[e] < 0.f ? -1.f : 0.f); }

    LAS unsigned char* stg = lds + LDS_AUX + 8192 + wave * 2304;
#define SC_LOAD(dst, tile) do { const bf16_t* kp_ = Kib + (size_t)((tile) * 32 + (lane >> 3)) * 64 + 8 * (lane & 7); \
        dst[0] = *(const bf16x8*)kp_; dst[1] = *(const bf16x8*)(kp_ + 8 * 64); dst[2] = *(const bf16x8*)(kp_ + 16 * 64); dst[3] = *(const bf16x8*)(kp_ + 24 * 64); } while (0)
#define SC_TILE(src, tloc) do { _Pragma("unroll") for (int c = 0; c < 2; ++c) { \
        *(LAS bf16x8*)(stg + (lane >> 3) * 144 + (lane & 7) * 16) = src[2 * c]; *(LAS bf16x8*)(stg + (8 + (lane >> 3)) * 144 + (lane & 7) * 16) = src[2 * c + 1]; \
        asm volatile("" ::: "memory"); __builtin_amdgcn_wave_barrier(); \
        const bf16x8 f0 = *(const LAS bf16x8*)(stg + j * 144 + 16 * kq), f1 = *(const LAS bf16x8*)(stg + j * 144 + 64 + 16 * kq); \
        asm volatile("" ::: "memory"); __builtin_amdgcn_wave_barrier(); \
        _Pragma("unroll") for (int qg = 0; qg < 2; ++qg) { \
        f32x4 d0 = (f32x4){0.f, 0.f, 0.f, 0.f}, d1 = (f32x4){0.f, 0.f, 0.f, 0.f}; \
        d0 = __builtin_amdgcn_mfma_f32_16x16x32_bf16(af[qg][0][0], f0, d0, 0, 0, 0); d1 = __builtin_amdgcn_mfma_f32_16x16x32_bf16(af[qg][1][0], f0, d1, 0, 0, 0); \
        d0 = __builtin_amdgcn_mfma_f32_16x16x32_bf16(af[qg][0][1], f1, d0, 0, 0, 0); d1 = __builtin_amdgcn_mfma_f32_16x16x32_bf16(af[qg][1][1], f1, d1, 0, 0, 0); \
        float sa = 0.f, sb = 0.f; \
        _Pragma("unroll") for (int r = 0; r < 4; ++r) { sa += sg[qg][r] * fmaxf(d0[r], 0.f); sb += sg[qg][4 + r] * fmaxf(d1[r], 0.f); } \
        SC[(4 * qg + kq) * 4096 + (tloc) * 32 + 16 * c + j] = sa + sb; } } } while (0)
#pragma unroll
    for (int half = 0; half < 2; ++half) {
        if (half * 4096 < nvis) {
            const int khi = nvis < half * 4096 + 4096 ? nvis : half * 4096 + 4096, ntiles = (khi - half * 4096 + 31) >> 5, tbase = half * 128;
            bf16x8 b0[4], b1[4], b2[4], b3[4];
            const int nk = (ntiles - wave + NWAVES - 1) / NWAVES;
            if (nk > 0) {
#define TLOC(k) (wave + NWAVES * ((k) < nk ? (k) : nk - 1))
                SC_LOAD(b0, tbase + TLOC(0)); SC_LOAD(b1, tbase + TLOC(1)); SC_LOAD(b2, tbase + TLOC(2)); __builtin_amdgcn_sched_barrier(0);
                for (int k = 0; k < nk; k += 4) {
                    SC_LOAD(b3, tbase + TLOC(k + 3)); __builtin_amdgcn_sched_barrier(0);
                    SC_TILE(b0, TLOC(k)); __builtin_amdgcn_sched_barrier(0);
                    SC_LOAD(b0, tbase + TLOC(k + 4)); __builtin_amdgcn_sched_barrier(0);
                    if (k + 1 < nk) SC_TILE(b1, TLOC(k + 1));
                    __builtin_amdgcn_sched_barrier(0);
                    SC_LOAD(b1, tbase + TLOC(k + 5)); __builtin_amdgcn_sched_barrier(0);
                    if (k + 2 < nk) SC_TILE(b2, TLOC(k + 2));
                    __builtin_amdgcn_sched_barrier(0);
                    SC_LOAD(b2, tbase + TLOC(k + 6)); __builtin_amdgcn_sched_barrier(0);
                    if (k + 3 < nk) SC_TILE(b3, TLOC(k + 3));
                    __builtin_amdgcn_sched_barrier(0);
                }
#undef TLOC
            }
            __syncthreads();
            if (nvis > 256) {
#pragma unroll
                for (int wb = 0; wb < 2; ++wb) {
                    const int w = 2 * half + wb;
                    if (w * 2048 < nvis) {
#pragma unroll
                        for (int k = 0; k < 32; ++k) key[32 * w + k] = f2key(sc[(32 * wb + k) * 64 + lane]);
                        TRANSPOSE32(32 * w);
                    } else {
#pragma unroll
                        for (int k = 0; k < 32; ++k) key[32 * w + k] = 0u;
                    }
                    __builtin_amdgcn_sched_barrier(0);
                }
            }
            if (half == 0 && nvis > 4096) __syncthreads();
        } else {
#pragma unroll
            for (int k = 0; k < 64; ++k) key[64 * half + k] = 0u;
        }
    }
#undef SC_LOAD
#undef SC_TILE
    if (nvis <= 256) { for (int p = lane; p < 256; p += 64) sel[p] = p < nvis ? sel_entry(p, qpos) : 0u; }
    else {
        unsigned A[4], GT[4];
        { const int nsl = (nvis - lane + 63) >> 6;
#pragma unroll
          for (int w = 0; w < 4; ++w) { const int r = nsl - 32 * w; A[w] = r >= 32 ? 0xffffffffu : (r > 0 ? ((1u << r) - 1u) : 0u); GT[w] = 0u; } }
        int cabove = 0; bool done = false;
#pragma unroll
        for (int bit = 31; bit >= 0; --bit) {
            if (!done) {
                unsigned ones[4]; int c = 0;
#pragma unroll
                for (int w = 0; w < 4; ++w) { ones[w] = A[w] & key[32 * w + bit]; c += __builtin_popcount(ones[w]); }
                const int tot = cabove + wave_sum_i(c);
                if (tot >= 256) {
#pragma unroll
                    for (int w = 0; w < 4; ++w) A[w] = ones[w];
                    if (tot == 256) {
#pragma unroll
                        for (int w = 0; w < 4; ++w) { GT[w] |= ones[w]; A[w] = 0u; }
                        cabove = 256; done = true; }
                } else {
#pragma unroll
                    for (int w = 0; w < 4; ++w) { GT[w] |= ones[w]; A[w] &= ~key[32 * w + bit]; }
                    cabove = tot; }
            }
        }
        const int cgt = cabove, need_eq = 256 - cgt;
        { int cl = 0;
#pragma unroll
          for (int w = 0; w < 4; ++w) cl += __builtin_popcount(GT[w]);
          int x = cl;
#pragma unroll
          for (int d = 1; d < 64; d <<= 1) { const int v = __shfl_up(x, d); if (lane >= d) x += v; }
          int pos = x - cl;
#pragma unroll
          for (int w = 0; w < 4; ++w) { unsigned mk = GT[w];
              while (mk) { const int i = __builtin_ctz(mk); mk &= mk - 1u; sel[pos++] = (unsigned)((32 * w + i) * 64 + lane); } } }
        if (need_eq > 0) { int base_eq = 0;
#pragma unroll
            for (int w = 0; w < 4; ++w) { unsigned U = wave_or_u(A[w]);
                while (U != 0u && base_eq < need_eq) { const int i = __builtin_ctz(U); U &= U - 1u;
                    const bool eq = (A[w] >> i) & 1u; const unsigned long long be = __ballot(eq);
                    const int re = base_eq + (int)__builtin_amdgcn_mbcnt_hi((unsigned)(be >> 32), __builtin_amdgcn_mbcnt_lo((unsigned)be, 0u));
                    if (eq && re < need_eq) sel[cgt + re] = (unsigned)((32 * w + i) * 64 + lane);
                    base_eq += __popcll(be); } } }
        lds_wait();
        { u32x4 e4 = *(LAS u32x4*)(sel + 4 * lane);
#pragma unroll
          for (int r = 0; r < 4; ++r) e4[r] = sel_entry((int)e4[r], qpos);
          *(LAS u32x4*)(sel + 4 * lane) = e4; }
    }
    { lds_wait(); unsigned* sg_ = (unsigned*)(a->ws + WS_SEL) + (size_t)(m0 + wave) * 256; *(u32x4*)(sg_ + 4 * lane) = *(const LAS u32x4*)(sel + 4 * lane); }
    __syncthreads();
}
#undef TRANSPOSE32

__device__ __forceinline__ float att_red_max(float v) {
    v = fmaxf(v, __int_as_float(__builtin_amdgcn_update_dpp(0, __float_as_int(v), 0x124, 0xf, 0xf, false)));
    v = fmaxf(v, __int_as_float(__builtin_amdgcn_update_dpp(0, __float_as_int(v), 0x128, 0xf, 0xf, false)));
    { auto r = __builtin_amdgcn_permlane16_swap(__float_as_uint(v), __float_as_uint(v), false, false); v = fmaxf(__uint_as_float(r[0]), __uint_as_float(r[1])); }
    { auto r = __builtin_amdgcn_permlane32_swap(__float_as_uint(v), __float_as_uint(v), false, false); v = fmaxf(__uint_as_float(r[0]), __uint_as_float(r[1])); }
    return v;
}
__device__ __forceinline__ float att_red_sum(float v) {
    v += __int_as_float(__builtin_amdgcn_update_dpp(0, __float_as_int(v), 0x124, 0xf, 0xf, false));
    v += __int_as_float(__builtin_amdgcn_update_dpp(0, __float_as_int(v), 0x128, 0xf, 0xf, false));
    { auto r = __builtin_amdgcn_permlane16_swap(__float_as_uint(v), __float_as_uint(v), false, false); v = __uint_as_float(r[0]) + __uint_as_float(r[1]); }
    { auto r = __builtin_amdgcn_permlane32_swap(__float_as_uint(v), __float_as_uint(v), false, false); v = __uint_as_float(r[0]) + __uint_as_float(r[1]); }
    return v;
}
constexpr int ATT_WAVE_LDS = 1024 + 32 * 160;
__device__ __forceinline__ void att_unit(ArgsP a, LAS unsigned char* lds, int m_in, int kvh) {
    int tid_ = threadIdx.x; asm volatile("" : "+v"(tid_)); const int tid = tid_, lane = tid & 63, wave = __builtin_amdgcn_readfirstlane(tid >> 6);
    const int m = m_in;
    const bf16_t *Kb, *Vb;
    if (m < MP) { const int b = m >> 13; Kb = (const bf16_t*)(a->ws + WS_KP) + (size_t)b * SEQ * 256; Vb = (const bf16_t*)(a->ws + WS_VP) + (size_t)b * SEQ * 256; }
    else { const int b = (m - MP) >> 4; Kb = (const bf16_t*)(a->ws + WS_KS) + (size_t)b * LTOT * 256; Vb = (const bf16_t*)(a->ws + WS_VS) + (size_t)b * LTOT * 256; }
    Kb += kvh * 64; Vb += kvh * 64;
    bf16_t* qb = (bf16_t*)(a->ws + WS_Q);
    LAS unsigned* sel = (LAS unsigned*)(lds + wave * ATT_WAVE_LDS);
    LAS unsigned char* vst = lds + wave * ATT_WAVE_LDS + 1024;
    const LAS float* REL = (const LAS float*)(lds + LDS_AUX + 4096);
    const int j = lane & 15, kq = lane >> 4;
    { const u32x4 e = *(const u32x4*)((const unsigned*)(a->ws + WS_SEL) + (size_t)m * 256 + 4 * lane); *(LAS u32x4*)(sel + 4 * lane) = e; }
    bf16x8 qf[2];
#pragma unroll
    for (int ks = 0; ks < 2; ++ks) { u32x4 w = (u32x4){0u, 0u, 0u, 0u};
        if (j < 4) w = *(const u32x4*)(qb + (size_t)m * 1024 + (kvh * 4 + j) * 64 + 32 * ks + 8 * kq);
        qf[ks] = __builtin_bit_cast(bf16x8, w); }
    lds_wait(); __builtin_amdgcn_wave_barrier();
    f32x4 S[16];
    {
        u32x4 kr[4][4];
#pragma unroll
        for (int s = 0; s < 3; ++s)
#pragma unroll
            for (int c = 0; c < 4; ++c) { const unsigned e = sel[32 * s + 8 * c + (lane >> 3)]; kr[s][c] = *(const u32x4*)((const char*)Kb + ((e & 0xffffu) * 512u + 16u * (unsigned)(lane & 7))); }
        __builtin_amdgcn_sched_barrier(0);
#pragma unroll
        for (int s = 0; s < 8; ++s) {
            if (s + 3 < 8) {
#pragma unroll
                for (int c = 0; c < 4; ++c) { const unsigned e = sel[32 * (s + 3) + 8 * c + (lane >> 3)]; kr[(s + 3) & 3][c] = *(const u32x4*)((const char*)Kb + ((e & 0xffffu) * 512u + 16u * (unsigned)(lane & 7))); }
            }
            __builtin_amdgcn_sched_barrier(0);
#pragma unroll
            for (int c = 0; c < 4; ++c) *(LAS u32x4*)(vst + (8 * c + (lane >> 3)) * 160 + (lane & 7) * 16) = kr[s & 3][c];
            asm volatile("" ::: "memory"); __builtin_amdgcn_wave_barrier();
#pragma unroll
            for (int tt = 0; tt < 2; ++tt) { const LAS unsigned char* p = vst + (16 * tt + j) * 160 + 16 * kq;
                const bf16x8 k0 = *(const LAS bf16x8*)p, k1 = *(const LAS bf16x8*)(p + 64);
                f32x4 sacc = (f32x4){0.f, 0.f, 0.f, 0.f};
                sacc = __builtin_amdgcn_mfma_f32_16x16x32_bf16(k0, qf[0], sacc, 0, 0, 0);
                sacc = __builtin_amdgcn_mfma_f32_16x16x32_bf16(k1, qf[1], sacc, 0, 0, 0);
                S[2 * s + tt] = sacc; }
            asm volatile("" ::: "memory"); __builtin_amdgcn_wave_barrier();
        }
    }
    u32x4 vr[4][4];
#pragma unroll
    for (int s = 0; s < 3; ++s)
#pragma unroll
        for (int c = 0; c < 4; ++c) { const unsigned e = sel[32 * s + 8 * c + (lane >> 3)]; vr[s][c] = *(const u32x4*)((const char*)Vb + ((e & 0xffffu) * 512u + 16u * (unsigned)(lane & 7))); }
    __builtin_amdgcn_sched_barrier(0);
    float L[16]; float mx = -3.0e38f;
#pragma unroll
    for (int t = 0; t < 16; ++t) {
        int pk = __float_as_int(S[t][0]);
        pk = __builtin_amdgcn_update_dpp(pk, __float_as_int(S[t][1]), 0x114, 0xf, 0x2, false);
        pk = __builtin_amdgcn_update_dpp(pk, __float_as_int(S[t][2]), 0x118, 0xf, 0x4, false);
        pk = __builtin_amdgcn_update_dpp(pk, __float_as_int(S[t][3]), 0x11c, 0xf, 0x8, false);
        const unsigned e = sel[16 * t + 4 * kq + (j >> 2)];
        const float bias = REL[((e >> 16) & 31u) * 16 + kvh * 4 + (j & 3)];
        const float l = (e >> 24) ? __int_as_float(pk) * 0.125f + bias : -1e30f; L[t] = l; mx = fmaxf(mx, l); }
    mx = att_red_max(mx);
    float sum = 0.f;
#pragma unroll
    for (int t = 0; t < 16; ++t) { const float p = __expf(L[t] - mx); L[t] = p; sum += p; }
    sum = att_red_sum(sum);
    bf16x8 pf[8];
#pragma unroll
    for (int s = 0; s < 8; ++s) { float P[2][4];
#pragma unroll
        for (int tt = 0; tt < 2; ++tt) { const int v = __float_as_int(L[2 * s + tt]);
            P[tt][0] = __int_as_float(j < 4 ? v : 0);
            P[tt][1] = __int_as_float(__builtin_amdgcn_update_dpp(0, v, 0x104, 0xf, 0x1, true));
            P[tt][2] = __int_as_float(__builtin_amdgcn_update_dpp(0, v, 0x108, 0xf, 0x1, true));
            P[tt][3] = __int_as_float(__builtin_amdgcn_update_dpp(0, v, 0x10c, 0xf, 0x1, true)); }
        u32x4 w; w.x = pkbf(P[0][0], P[0][1]); w.y = pkbf(P[0][2], P[0][3]); w.z = pkbf(P[1][0], P[1][1]); w.w = pkbf(P[1][2], P[1][3]);
        pf[s] = __builtin_bit_cast(bf16x8, w); }
    f32x4 O[4];
#pragma unroll
    for (int dt = 0; dt < 4; ++dt) O[dt] = (f32x4){0.f, 0.f, 0.f, 0.f};
#pragma unroll
    for (int s = 0; s < 8; ++s) {
        if (s + 3 < 8) {
#pragma unroll
            for (int c = 0; c < 4; ++c) { const unsigned e = sel[32 * (s + 3) + 8 * c + (lane >> 3)]; vr[(s + 3) & 3][c] = *(const u32x4*)((const char*)Vb + ((e & 0xffffu) * 512u + 16u * (unsigned)(lane & 7))); }
        }
        __builtin_amdgcn_sched_barrier(0);
#pragma unroll
        for (int c = 0; c < 4; ++c) *(LAS u32x4*)(vst + (8 * c + (lane >> 3)) * 160 + (lane & 7) * 16) = vr[s & 3][c];
        asm volatile("" ::: "memory"); __builtin_amdgcn_wave_barrier();
#pragma unroll
        for (int dt = 0; dt < 4; ++dt) { const LAS unsigned char* p = vst + (4 * kq + (j >> 2)) * 160 + (16 * dt + 4 * (j & 3)) * 2;
            const s16x4 lo = tr_read(p), hi = tr_read(p + 16 * 160);
            const bf16x8 vf = (bf16x8){lo[0], lo[1], lo[2], lo[3], hi[0], hi[1], hi[2], hi[3]};
            O[dt] = __builtin_amdgcn_mfma_f32_16x16x32_bf16(pf[s], vf, O[dt], 0, 0, 0); }
        asm volatile("" ::: "memory"); __builtin_amdgcn_wave_barrier();
    }
    float inv[4];
#pragma unroll
    for (int r = 0; r < 4; ++r) inv[r] = 1.0f / __shfl(sum, r);
    if (kq == 0) {
#pragma unroll
        for (int r = 0; r < 4; ++r) { bf16_t* op = qb + (size_t)m * 1024 + (kvh * 4 + r) * 64 + j;
#pragma unroll
            for (int dt = 0; dt < 4; ++dt) op[16 * dt] = (bf16_t)(pkbf(O[dt][r] * inv[r], 0.f) & 0xffffu); }
    }
}

#define XB_TMO      128
#define XB_XCNT(j)  (256  + 64 * (j))
#define XB_XSUB(j)  (1280 + 64 * (j))
#define XB_XGEN(j)  (2304 + 64 * (j))
#define XB_TOP      3328
#define XB_TOPGEN   3392
#define XCD_BAR_WORDS 3456
#define XB_SPIN_CAP (1u << 18)

__device__ __forceinline__ unsigned xb_ld(unsigned* p)              { return __hip_atomic_load(p, __ATOMIC_RELAXED, __HIP_MEMORY_SCOPE_AGENT); }
__device__ __forceinline__ unsigned xb_add(unsigned* p, unsigned v) { return __hip_atomic_fetch_add(p, v, __ATOMIC_RELAXED, __HIP_MEMORY_SCOPE_AGENT); }
__device__ __forceinline__ unsigned xb_xcc_id() { return (unsigned)__builtin_amdgcn_s_getreg((3 << 11) | 20) & 0xFu; }
#define XB_SPIN(cond, bar) do { unsigned _sp = 0; while (cond) { __builtin_amdgcn_s_sleep(1); \
    if ((++_sp & 255u) == 0u) { if (xb_ld(&(bar)[XB_TMO])) break; if (_sp > XB_SPIN_CAP) { atomicAdd(&(bar)[XB_TMO], 1u); break; } } } } while (0)

struct XcdBarrier {
    unsigned* bar; unsigned x;
    volatile LAS unsigned* st;
};

__device__ __forceinline__ XcdBarrier xcd_barrier_post(unsigned* bar, volatile LAS unsigned* st) {
    XcdBarrier b; b.bar = bar; b.x = xb_xcc_id(); b.st = st;
    if (threadIdx.x == 0) (void)xb_add(&bar[XB_XCNT(b.x)], 1u);
    return b;
}
__device__ __forceinline__ void xcd_barrier_complete(unsigned* bar, unsigned x, unsigned& nloc, unsigned& nx) {
    const unsigned G = gridDim.x * gridDim.y * gridDim.z;
    unsigned sum, cnt, mine, sp = 0u;
    for (;;) {
        sum = 0u; cnt = 0u; mine = 0u;
#pragma unroll
        for (unsigned j = 0; j < 16; ++j) { const unsigned c = xb_ld(&bar[XB_XCNT(j)]); sum += c; cnt += (c > 0u) ? 1u : 0u; mine = (j == x) ? c : mine; }
        if (sum == G) break;
        __builtin_amdgcn_s_sleep(1);
        if ((++sp & 255u) == 0u) { if (xb_ld(&bar[XB_TMO])) break; if (sp > XB_SPIN_CAP) { atomicAdd(&bar[XB_TMO], 1u); break; } }
    }
    nloc = mine > 0u ? mine : 1u; nx = cnt > 0u ? cnt : 1u;
}

__device__ __forceinline__ void xcd_barrier(const XcdBarrier& b) {
    asm volatile("s_waitcnt vmcnt(0)" ::: "memory");
    __syncthreads();
    if (threadIdx.x == 0) {
        unsigned* bar = b.bar;
        __builtin_amdgcn_s_waitcnt(0);
        unsigned nloc = b.st[0], nx = b.st[1];
        if (nloc == 0u) { xcd_barrier_complete(bar, b.x, nloc, nx); b.st[0] = nloc; b.st[1] = nx; }
        const unsigned old = xb_add(&bar[XB_XSUB(b.x)], 1u);
        const unsigned gen = old / nloc;
        if (old + 1u == (gen + 1u) * nloc) {
            __builtin_amdgcn_fence(__ATOMIC_RELEASE, "agent");
            asm volatile("s_waitcnt vmcnt(0)" ::: "memory");
            const unsigned og = xb_add(&bar[XB_TOP], 1u);
            const unsigned tg = og / nx;
            if (og + 1u == (tg + 1u) * nx) xb_add(&bar[XB_TOPGEN], 1u);
            else XB_SPIN(xb_ld(&bar[XB_TOPGEN]) == tg, bar);
            __builtin_amdgcn_fence(__ATOMIC_ACQUIRE, "agent");
            xb_add(&bar[XB_XGEN(b.x)], 1u);
            asm volatile("s_waitcnt vmcnt(0)" ::: "memory");
        } else {
            XB_SPIN(xb_ld(&bar[XB_XGEN(b.x)]) == gen, bar);
            __builtin_amdgcn_fence(__ATOMIC_ACQUIRE, "agent");
            asm volatile("s_waitcnt vmcnt(0)" ::: "memory");
        }
    }
    __syncthreads();
}

__global__ void __launch_bounds__(NTHREADS, 2) fwd_megakernel(Args args_unused) {
    extern __shared__ __attribute__((aligned(16))) unsigned char lds_raw[];
    LAS unsigned char* lds = (LAS unsigned char*)lds_raw;
    cg::grid_group grid = cg::this_grid();
    const int G = gridDim.x, tid = threadIdx.x;
    ArgsP ap = (ArgsP)__builtin_amdgcn_kernarg_segment_ptr();
    unsigned char* ws; float* out;
#define FRESH() do { asm volatile("" : "+s"(ap)); ws = ap->ws; out = ap->out; } while (0)
#define args (*ap)
#define ARGP ap
    FRESH();
    volatile LAS unsigned* bst = (volatile LAS unsigned*)(lds + LDS_BYTES - 64);
    if (tid < 2) bst[tid] = 0u;
    if (blockIdx.x == 0) for (int i = tid; i < XCD_BAR_WORDS; i += NTHREADS) ((unsigned*)(ws + WS_BAR))[i] = 0u;
    if (blockIdx.x == 0 && tid < 4) ((unsigned*)(ws + WS_BAR + 16384))[tid * 64] = 0u;
#ifndef PHM
#define PHM 0xffff
#endif
#define HAS(k) ((PHM >> (k)) & 1)
#define GEMM_UP(Aptr, Woff) do { if (HAS(1)) { pg8::Gemm g{Aptr, (const bf16_t*)(ws + (Woff)), MT, NUP, 1024}; pg8::StaticOrder S; S.init(MT, NUP, G, (int)blockIdx.x); \
        pg8::EpiUp E{(bf16_t*)(ws + WS_HID)}; pg8::gemm_phase<pg8::EpiUp, pg8::StaticOrder, true, true>(lds, g, S, E); } } while (0)
#define GEMM_DOWN(Aptr, Woff, KK, RESB, SCALE, PREOFF) do { if (HAS(2)) { pg8::Gemm g{Aptr, (const bf16_t*)(ws + (Woff)), MT, 1024, KK}; pg8::StaticOrder S; S.init(MT, 1024, G, (int)blockIdx.x); \
        pg8::EpiDown E{(bf16_t*)(ws + (PREOFF)), args.in[0], args.in[1], RESB, SCALE}; pg8::gemm_phase<pg8::EpiDown, pg8::StaticOrder, true, true>(lds, g, S, E); } } while (0)
#define GEMM_BR(Aptr, Woff, GATE, MODE) do { if (HAS(7)) { pg8::Gemm g{Aptr, (const bf16_t*)(ws + (Woff)), MT, 1024, 1024}; pg8::StaticOrder S; S.init(MT, 1024, G, (int)blockIdx.x); \
        pg8::EpiBr E{(bf16_t*)(ws + WS_VPRE), GATE, MODE}; pg8::gemm_phase<pg8::EpiBr, pg8::StaticOrder, true, true>(lds, g, S, E); } } while (0)
    if (HAS(0)) prologue(ap, lds, G);
    grid.sync(); FRESH();
    XcdBarrier xbar = xcd_barrier_post((unsigned*)(ws + WS_BAR), bst);
#define GSYNC() do { xbar.bar = (unsigned*)(ws + WS_BAR); xcd_barrier(xbar); FRESH(); } while (0)
    GEMM_UP((const bf16_t*)(ws + WS_XB), WS_W1U);
    GSYNC();
    GEMM_DOWN((const bf16_t*)(ws + WS_HID), WS_W1D, FF, (const bf16_t*)nullptr, 0.5f, WS_PRE1);
    GSYNC();
    if (HAS(3)) ln_phase((const bf16_t*)(ws + WS_PRE1), args.in[6], args.in[7], (bf16_t*)(ws + WS_H1), nullptr, G);
    GSYNC();
    if (HAS(4)) { pg8::Gemm g{(const bf16_t*)(ws + WS_H1), (const bf16_t*)(ws + WS_WIN), MT, NWIN, 1024}; pg8::StaticOrder S; S.init(MT, NWIN, G, (int)blockIdx.x);
        pg8::EpiWin E{ws, out}; pg8::gemm_phase<pg8::EpiWin, pg8::StaticOrder, true, true>(lds, g, S, E); }
    GSYNC();
    if (HAS(5)) for (int u = blockIdx.x; u < 544; u += G) gate_unit(ap, lds, u);
    if (HAS(6)) {
        if (G == 256) {
            const int k = blockIdx.x;
            if (k < 64) sel_unit(ap, lds, k);
            for (int i = 0; i < 32; ++i) { const int r = i & 3, p = (r & 1) ? (256 * (r + 1) - 1 - k) : (256 * r + k); sel_unit(ap, lds, 64 + (i >> 2) * 1024 + p); }
        } else for (int u = blockIdx.x; u < 64 + 8192; u += G) sel_unit(ap, lds, u);
    }
    GSYNC();
    if (HAS(6)) { { LAS float* REL = (LAS float*)(lds + LDS_AUX + 4096); if (tid < 512) REL[tid] = args.in[5][tid]; }
        __syncthreads();
        if ((G & 7) == 0) { const int bid = blockIdx.x, kvh = bid & 3, par = (bid >> 2) & 1, rank = bid >> 3, nrank = G >> 3;
            (void)par; (void)rank; (void)nrank;
            unsigned* qh = (unsigned*)(ws + WS_BAR + 16384) + kvh * 64;
            const int lane_ = tid & 63;
            unsigned mq = 0u; if (lane_ == 0) mq = __hip_atomic_fetch_add(qh, 1u, __ATOMIC_RELAXED, __HIP_MEMORY_SCOPE_AGENT);
            int m = __builtin_amdgcn_readfirstlane((int)mq);
            while (m < MT) {
                unsigned mn = 0u; if (lane_ == 0) mn = __hip_atomic_fetch_add(qh, 1u, __ATOMIC_RELAXED, __HIP_MEMORY_SCOPE_AGENT);
                att_unit(ap, lds, m, kvh);
                m = __builtin_amdgcn_readfirstlane((int)mn);
            } }
        else for (int u = blockIdx.x; u < (MT / 8) * 4; u += G) { const int wv = __builtin_amdgcn_readfirstlane(tid >> 6); att_unit(ap, lds, (u >> 2) * 8 + wv, u & 3); } }
    GSYNC();
    GEMM_BR((const bf16_t*)(ws + WS_Q), WS_WA, (const bf16_t*)out, 0);
    FRESH();
    GEMM_BR((const bf16_t*)(ws + WS_U), WS_WB, (const bf16_t*)out + (size_t)MT * 1024, 1);
    GSYNC();
    GEMM_DOWN((const bf16_t*)(ws + WS_VPRE), WS_WO, 1024, (const bf16_t*)(ws + WS_H1), 1.0f, WS_PRE2);
    GSYNC();
    if (HAS(3)) ln_phase((const bf16_t*)(ws + WS_PRE2), args.in[19], args.in[20], (bf16_t*)(ws + WS_XB), nullptr, G);
    GSYNC();
    GEMM_UP((const bf16_t*)(ws + WS_XB), WS_W2U);
    GSYNC();
    GEMM_DOWN((const bf16_t*)(ws + WS_HID), WS_W2D, FF, (const bf16_t*)(ws + WS_XB), 0.5f, WS_PRE3);
    GSYNC();
    if (HAS(3)) ln_phase((const bf16_t*)(ws + WS_PRE3), args.in[24], args.in[25], nullptr, out, G);
#undef args
}

extern "C" void kernel_launch(void* const* d_in, const int* in_sizes, int n_in, void* d_out, int out_size, void* d_ws, size_t ws_size, hipStream_t stream) {
    static int grid = 0;
    if (grid == 0) {
        if (n_in != 26 || ws_size < WS_END || (size_t)out_size != O_END || ws_size < 1024 * MiB) { fprintf(stderr, "kernel_launch: unexpected shapes n_in %d out %d ws %zu\n", n_in, out_size, ws_size); grid = -1; return; }
        int dev = 0, cus = 0, per_cu = 0;
        hipGetDevice(&dev); hipDeviceGetAttribute(&cus, hipDeviceAttributeMultiprocessorCount, dev);
        if (hipFuncSetAttribute((const void*)fwd_megakernel, hipFuncAttributeMaxDynamicSharedMemorySize, LDS_BYTES) != hipSuccess) { fprintf(stderr, "kernel_launch: hipFuncSetAttribute failed\n"); grid = -1; return; }
        if (hipOccupancyMaxActiveBlocksPerMultiprocessor(&per_cu, (const void*)fwd_megakernel, NTHREADS, LDS_BYTES) != hipSuccess || per_cu < 1) { fprintf(stderr, "kernel_launch: occupancy query says %d\n", per_cu); per_cu = 1; }
        (void)hipGetLastError();
        grid = cus * per_cu;
    }
    if (grid < 0) return;
    Args a{};
    for (int i = 0; i < 26; ++i) a.in[i] = (const float*)d_in[i];
    a.out = (float*)d_out; a.ws = (unsigned char*)d_ws;
    void* kargs[] = {&a};
    hipError_t e = hipLaunchCooperativeKernel((const void*)fwd_megakernel, dim3(grid), dim3(NTHREADS), kargs, LDS_BYTES, stream);
    if (e != hipSuccess) fprintf(stderr, "cooperative launch failed: %s (grid %d)\n", hipGetErrorString(e), grid);
}
```
